# Optimizing an MI355X kernel written in HIP

```python
import jax, jax.numpy as jnp
from jax import lax
import numpy as np

D_MODEL = 1024
BATCH = 2
SEQ = 8192
DEPTH = 4
DEC_BATCH = 16
DEC_SEQ = 16
PAST_LEN = 4096

CHUNK = 64
FOX_HEAD_DIM = 64
N_FOX_HEADS = D_MODEL // 128
FOX_WIDTH = N_FOX_HEADS * FOX_HEAD_DIM
FOX_SCALE = FOX_HEAD_DIM ** -0.5
Q_BLOCK = 128
POOL_WINDOWS = (2, 4, 8, 16)
POOL_WIDTH = D_MODEL // 2
POOL_GROUP = POOL_WIDTH // len(POOL_WINDOWS)
POOL_HIST = max(POOL_WINDOWS) - 1
N_MEM = 256
N_MEM_HEADS = 4
MEM_HEAD_DIM = D_MODEL // 8
MEM_WIDTH = N_MEM_HEADS * MEM_HEAD_DIM
MEM_SCALE = MEM_HEAD_DIM ** -0.5
N_BRANCH = 3
D_FF = 2816
CONV_WIDTH = 3
CONV_HIST = CONV_WIDTH - 1
EPS = 1e-6
NEG_INF = -1e30
O_Q = 0
O_K = O_Q + FOX_WIDTH
O_V = O_K + FOX_WIDTH
O_F = O_V + FOX_WIDTH
O_P = O_F + N_FOX_HEADS
O_M = O_P + POOL_WIDTH
O_G = O_M + MEM_WIDTH
IN_COLS = O_G + N_BRANCH * D_MODEL

kernel_name = 'fox_pool_mem_stream_encoder'


def rms_norm(x, g):
    xf = x.astype(jnp.float32)
    y = xf * lax.rsqrt(jnp.mean(xf * xf, axis=-1, keepdims=True) + EPS)
    return (y * g.astype(jnp.float32)).astype(x.dtype)


def fox_attention(q, k, v, cq, ck, q_pos, k_pos):
    b, t, h, d = q.shape
    ck_t = jnp.transpose(ck, (0, 2, 1))[:, :, None, :]

    def block(args):
        qb, cqb, pb = args
        s = jnp.einsum('bqhd,bkhd->bhqk', qb, k).astype(jnp.float32) * FOX_SCALE
        s = s + jnp.transpose(cqb, (0, 2, 1))[..., None] - ck_t
        s = jnp.where((k_pos[None, :] <= pb[:, None])[None, None], s, NEG_INF)
        p = jax.nn.softmax(s, axis=-1).astype(v.dtype)
        return jnp.einsum('bhqk,bkhd->bqhd', p, v)

    if t <= Q_BLOCK:
        return block((q, cq, q_pos))
    nb = t // Q_BLOCK
    qs = jnp.moveaxis(q.reshape(b, nb, Q_BLOCK, h, d), 1, 0)
    cqs = jnp.moveaxis(cq.reshape(b, nb, Q_BLOCK, h), 1, 0)
    ps = q_pos.reshape(nb, Q_BLOCK)
    out = lax.map(block, (qs, cqs, ps))
    return jnp.moveaxis(out, 0, 1).reshape(b, t, h, d)


def pool_mixer(u, u_hist, pos0, w_pool, pool_scale):
    b, t, _ = u.shape
    u_pad = jnp.concatenate([u_hist.astype(u.dtype), u], axis=1)
    cs = jnp.pad(jnp.cumsum(u_pad.astype(jnp.float32), axis=1), ((0, 0), (1, 0), (0, 0)))
    pos = pos0 + jnp.arange(t)
    means = []
    for g, w in enumerate(POOL_WINDOWS):
        c = cs[..., g * POOL_GROUP:(g + 1) * POOL_GROUP]
        s = c[:, POOL_HIST + 1:] - c[:, POOL_HIST + 1 - w:POOL_HIST + 1 - w + t]
        cnt = jnp.minimum(pos + 1, w).astype(jnp.float32)
        means.append(s / cnt[None, :, None])
    mix = (jnp.concatenate(means, axis=-1) - u.astype(jnp.float32)).astype(u.dtype)
    mix = mix.reshape(b, t, len(POOL_WINDOWS), POOL_GROUP)
    y = jnp.einsum('btgc,gcd->btgd', mix, w_pool).reshape(b, t, POOL_WIDTH) * pool_scale
    return y, u_pad[:, -POOL_HIST:]


def memory_kv(mem, g, w):
    b, n, _ = mem.shape
    mk, mv = jnp.split(rms_norm(mem, g) @ w, 2, axis=-1)
    return (mk.reshape(b, n, N_MEM_HEADS, MEM_HEAD_DIM), mv.reshape(b, n, N_MEM_HEADS, MEM_HEAD_DIM))


def memory_attention(mq, mk, mv):
    s = jnp.einsum('bthd,bmhd->bhtm', mq, mk).astype(jnp.float32) * MEM_SCALE
    p = jax.nn.softmax(s, axis=-1).astype(mv.dtype)
    return jnp.einsum('bhtm,bmhd->bthd', p, mv)


def conv_ffn(x, hist, w_up, conv_w, conv_b, w_down):
    t = x.shape[1]
    up = x @ w_up
    up_pad = jnp.concatenate([hist.astype(up.dtype), up], axis=1)
    z = up_pad[:, 0:t] * conv_w[0]
    for j in range(1, CONV_WIDTH):
        z = z + up_pad[:, j:j + t] * conv_w[j]
    z = z + conv_b
    gate, val = jnp.split(z, 2, axis=-1)
    h = jax.nn.gelu(gate, approximate=True) * val
    return h @ w_down, up_pad[:, -CONV_HIST:]


def layer(x, k_hist, v_hist, lf_hist, pool_hist, conv_hist, mem_k, mem_v,
          w_in, b_forget, b_gate, w_pool, pool_scale, w_br_fox, w_br_pool, w_br_mem, w_out,
          pre_mix_g, post_mix_g, pre_ffn_g, post_ffn_g, w_up, conv_w, conv_b, w_down):
    b, t, _ = x.shape
    past = k_hist.shape[1]
    h = rms_norm(x, pre_mix_g)
    proj = h @ w_in
    q = proj[..., O_Q:O_K].reshape(b, t, N_FOX_HEADS, FOX_HEAD_DIM)
    k = proj[..., O_K:O_V].reshape(b, t, N_FOX_HEADS, FOX_HEAD_DIM)
    v = proj[..., O_V:O_F].reshape(b, t, N_FOX_HEADS, FOX_HEAD_DIM)
    lf = jax.nn.log_sigmoid(proj[..., O_F:O_P].astype(jnp.float32) + b_forget.astype(jnp.float32))
    pu = proj[..., O_P:O_M]
    mq = proj[..., O_M:O_G].reshape(b, t, N_MEM_HEADS, MEM_HEAD_DIM)
    gates = jax.nn.sigmoid(proj[..., O_G:].astype(jnp.float32) + b_gate.astype(jnp.float32))
    gates = gates.astype(x.dtype).reshape(b, t, N_BRANCH, D_MODEL)

    k_all = jnp.concatenate([k_hist.astype(k.dtype), k], axis=1)
    v_all = jnp.concatenate([v_hist.astype(v.dtype), v], axis=1)
    c_all = jnp.cumsum(jnp.concatenate([lf_hist.astype(jnp.float32), lf], axis=1), axis=1)
    a = fox_attention(q, k_all, v_all, c_all[:, past:], c_all,
                      past + jnp.arange(t), jnp.arange(past + t)).reshape(b, t, FOX_WIDTH)
    p, pool_new = pool_mixer(pu, pool_hist, past, w_pool, pool_scale)
    m = memory_attention(mq, mem_k.astype(mq.dtype), mem_v.astype(mq.dtype)).reshape(b, t, MEM_WIDTH)

    merged = (gates[:, :, 0] * (a @ w_br_fox) + gates[:, :, 1] * (p @ w_br_pool)
              + gates[:, :, 2] * (m @ w_br_mem))
    x = x + rms_norm(merged @ w_out, post_mix_g)
    f_out, conv_new = conv_ffn(rms_norm(x, pre_ffn_g), conv_hist, w_up, conv_w, conv_b, w_down)
    x = x + rms_norm(f_out, post_ffn_g)
    return x, k, v, lf, pool_new, conv_new


def setup_inputs(seed: int = 0) -> dict:
    key = jax.random.key(seed)
    ks = jax.random.split(key, 32)
    f32 = jnp.float32
    nrm = lambda k_, shape, s=1.0: jax.random.normal(k_, shape, f32) * s
    head_bias = jnp.linspace(1.0, 6.0, N_FOX_HEADS, dtype=f32)
    return {
        'x_prompt': nrm(ks[0], (BATCH, SEQ, D_MODEL)),
        'x_sample': nrm(ks[1], (DEC_BATCH, DEC_SEQ, D_MODEL)),
        'cache_k': nrm(ks[2], (DEPTH, DEC_BATCH, PAST_LEN, N_FOX_HEADS, FOX_HEAD_DIM)),
        'cache_v': nrm(ks[3], (DEPTH, DEC_BATCH, PAST_LEN, N_FOX_HEADS, FOX_HEAD_DIM)),
        'cache_logf': jax.nn.log_sigmoid(nrm(ks[4], (DEPTH, DEC_BATCH, PAST_LEN, N_FOX_HEADS)) + head_bias),
        'state_pool': nrm(ks[5], (DEPTH, DEC_BATCH, POOL_HIST, POOL_WIDTH)),
        'state_conv': nrm(ks[6], (DEPTH, DEC_BATCH, CONV_HIST, 2 * D_FF)),
        'cache_mem_k': nrm(ks[7], (DEPTH, DEC_BATCH, N_MEM, N_MEM_HEADS, MEM_HEAD_DIM)),
        'cache_mem_v': nrm(ks[8], (DEPTH, DEC_BATCH, N_MEM, N_MEM_HEADS, MEM_HEAD_DIM)),
        'mem_prompt': nrm(ks[9], (BATCH, N_MEM, D_MODEL)),
        'w_in': nrm(ks[10], (DEPTH, D_MODEL, IN_COLS), D_MODEL ** -0.5),
        'b_forget': head_bias + nrm(ks[11], (DEPTH, N_FOX_HEADS), 0.1),
        'b_gate': nrm(ks[12], (DEPTH, N_BRANCH * D_MODEL), 0.1),
        'w_pool': nrm(ks[13], (DEPTH, len(POOL_WINDOWS), POOL_GROUP, POOL_GROUP), POOL_GROUP ** -0.5),
        'pool_scale': 1.0 + nrm(ks[14], (DEPTH, POOL_WIDTH), 0.1),
        'w_mem_kv': nrm(ks[15], (DEPTH, D_MODEL, 2 * MEM_WIDTH), D_MODEL ** -0.5),
        'mem_norm_g': 1.0 + nrm(ks[16], (DEPTH, D_MODEL), 0.1),
        'w_br_fox': nrm(ks[17], (DEPTH, FOX_WIDTH, D_MODEL), FOX_WIDTH ** -0.5),
        'w_br_pool': nrm(ks[18], (DEPTH, POOL_WIDTH, D_MODEL), POOL_WIDTH ** -0.5),
        'w_br_mem': nrm(ks[19], (DEPTH, MEM_WIDTH, D_MODEL), MEM_WIDTH ** -0.5),
        'w_out': nrm(ks[20], (DEPTH, D_MODEL, D_MODEL), D_MODEL ** -0.5),
        'pre_mix_g': 1.0 + nrm(ks[21], (DEPTH, D_MODEL), 0.1),
        'post_mix_g': 1.0 + nrm(ks[22], (DEPTH, D_MODEL), 0.1),
        'pre_ffn_g': 1.0 + nrm(ks[23], (DEPTH, D_MODEL), 0.1),
        'post_ffn_g': 1.0 + nrm(ks[24], (DEPTH, D_MODEL), 0.1),
        'w_up': nrm(ks[25], (DEPTH, D_MODEL, 2 * D_FF), D_MODEL ** -0.5),
        'conv_w': nrm(ks[26], (DEPTH, CONV_WIDTH, 2 * D_FF), CONV_WIDTH ** -0.5),
        'conv_b': nrm(ks[27], (DEPTH, 2 * D_FF), 0.02),
        'w_down': nrm(ks[28], (DEPTH, D_FF, D_MODEL), D_FF ** -0.5),
    }


def reference(x_prompt, x_sample, cache_k, cache_v, cache_logf, state_pool, state_conv,
              cache_mem_k, cache_mem_v, mem_prompt, w_in, b_forget, b_gate, w_pool, pool_scale,
              w_mem_kv, mem_norm_g, w_br_fox, w_br_pool, w_br_mem, w_out, pre_mix_g, post_mix_g,
              pre_ffn_g, post_ffn_g, w_up, conv_w, conv_b, w_down):
    bp = x_prompt.shape[0]
    dt = x_prompt.dtype
    k0 = jnp.zeros((bp, 0, N_FOX_HEADS, FOX_HEAD_DIM), dt)
    lf0 = jnp.zeros((bp, 0, N_FOX_HEADS), jnp.float32)
    pool0 = jnp.zeros((bp, POOL_HIST, POOL_WIDTH), dt)
    conv0 = jnp.zeros((bp, CONV_HIST, 2 * D_FF), dt)
    xp, xs = x_prompt, x_sample
    kp_l, vp_l, lfp_l, poolp_l, convp_l, mkp_l, mvp_l = [], [], [], [], [], [], []
    ks_l, vs_l, lfs_l, pools_l, convs_l = [], [], [], [], []
    for l in range(DEPTH):
        lw = (w_in[l], b_forget[l], b_gate[l], w_pool[l], pool_scale[l], w_br_fox[l], w_br_pool[l],
              w_br_mem[l], w_out[l], pre_mix_g[l], post_mix_g[l], pre_ffn_g[l], post_ffn_g[l],
              w_up[l], conv_w[l], conv_b[l], w_down[l])
        mk, mv = memory_kv(mem_prompt, mem_norm_g[l], w_mem_kv[l])
        xp, kp, vp, lfp, poolp, convp = layer(xp, k0, k0, lf0, pool0, conv0, mk, mv, *lw)
        kp_l.append(kp); vp_l.append(vp); lfp_l.append(lfp); poolp_l.append(poolp)
        convp_l.append(convp); mkp_l.append(mk); mvp_l.append(mv)
        xs, kn, vn, lfn, pooln, convn = layer(xs, cache_k[l], cache_v[l], cache_logf[l], state_pool[l],
                                              state_conv[l], cache_mem_k[l], cache_mem_v[l], *lw)
        ks_l.append(kn); vs_l.append(vn); lfs_l.append(lfn); pools_l.append(pooln); convs_l.append(convn)
    return (xp, xs,
            jnp.stack(kp_l), jnp.stack(vp_l), jnp.stack(lfp_l), jnp.stack(poolp_l), jnp.stack(convp_l),
            jnp.stack(mkp_l), jnp.stack(mvp_l),
            jnp.stack(ks_l), jnp.stack(vs_l), jnp.stack(lfs_l), jnp.stack(pools_l), jnp.stack(convs_l))
```

```cpp
#define N_LAUNCH_MODE 0
#include <hip/hip_bf16.h>
#include <cmath>
#include <hip/hip_runtime.h>
#include <cstdio>
#include <cstdint>
namespace pg8 {
#define PG8_LAS __attribute__((address_space(3)))
typedef unsigned short bf16_t;
typedef short bf16x8 __attribute__((ext_vector_type(8)));
typedef float f32x4 __attribute__((ext_vector_type(4)));
typedef unsigned u32x4 __attribute__((ext_vector_type(4)));
constexpr int BM = 256, BK = 64, HALF = 128, HTB = HALF * BK * 2  , STAGE_BYTES = 8 * HTB, NXCD = 8, WGM = 8;

__host__ __device__ __forceinline__ int lds_byte(int r, int c) { const int st = (r >> 4) * 2 + (c >> 5), rr = r & 15, cc = c & 31, ob = rr * 64 + cc * 2; return st * 1024 + (ob ^ (((ob >> 9) & 1) << 5)); }
__host__ __device__ __forceinline__ void stage_rc(int b, int& R, int& C) { const int st = b / 1024, sb = b % 1024, swz = sb ^ (((sb >> 9) & 1) << 5); R = (st >> 1) * 16 + swz / 64; C = (st & 1) * 32 + (swz % 64) / 2; }
__host__ __device__ __forceinline__ int perm32(int rho) { const int n = rho >> 4, i = rho & 15; return 8 * (i >> 2) + 4 * n + (i & 3); }

struct Unit { int pm, pn; };
struct Gemm { const bf16_t* A; const bf16_t* Bt; int M, N, K; };

struct StaticOrder {
    int nM, nN, nwg, G, c;
    __host__ __device__ void init(int M, int N, int G_, int c_) { nM = M / BM; nN = N / BM; nwg = nM * nN; G = G_; c = c_; }
    __host__ __device__ bool next(int i, Unit& u) const {
        const long L = (long)i * G + c; if (L >= nwg) return false;
        int wgid = (int)L; { const int q = nwg / NXCD, r = nwg % NXCD, xcd = wgid % NXCD, off = wgid / NXCD; wgid = (xcd < r ? xcd * (q + 1) : r * (q + 1) + (xcd - r) * q) + off; }
        const int nig = WGM * nN, gid = wgid / nig, fm = gid * WGM, gsz = (nM - fm) < WGM ? (nM - fm) : WGM;
        u.pm = fm + ((wgid % nig) % gsz); u.pn = (wgid % nig) / gsz; return true;
    }
    __device__ __forceinline__ void a_ready(const Unit&) const {}
    __device__ __forceinline__ void done(const Unit&) const {}
};

__device__ __forceinline__ unsigned cvt_pk_bf16(float lo, float hi) { unsigned r; asm volatile("v_cvt_pk_bf16_f32 %0, %1, %2" : "=v"(r) : "v"(lo), "v"(hi)); return r; }
typedef float f32x2 __attribute__((ext_vector_type(2)));
__device__ __forceinline__ f32x2 gelu_pk(f32x2 v) {
    const f32x2 av = __builtin_elementwise_abs(v), d = av * 0.2316418882f + 1.0f;
    f32x2 t; t.x = __builtin_amdgcn_rcpf(d.x); t.y = __builtin_amdgcn_rcpf(d.y);
    f32x2 q = t * 0.5307027145f + (-0.7265760135f); q = q * t + 0.7107068705f; q = q * t + (-0.142248368f); q = q * t + 0.127414796f; q = q * t;
    const f32x2 s = (v * v) * (-0.72134752044f);
    f32x2 e; e.x = __builtin_amdgcn_exp2f(s.x); e.y = __builtin_amdgcn_exp2f(s.y);
    const f32x2 m = v * (q * e), r = v - m;
    f32x2 o; o.x = v.x < 0.f ? m.x : r.x; o.y = v.y < 0.f ? m.y : r.y; return o;
}

template <int ACT  > struct EpiBf16 {
    static constexpr bool PERM = true, AFTER_DRAIN = false; static_assert(ACT == 0 || ACT == 1, "EpiBf16: ACT is 0 (none) or 1 (gelu_pk)");
    bf16_t* O; int ldc; const float* bias; int split_cols; size_t split_stride; float scale0;
    __device__ __forceinline__ void operator()(const f32x4 (&acc)[2][2][4][2], const Unit& u, int wr, int wc, int fr, int fq) const {
        const int row0 = u.pm * BM + wr * 64 + fr; int colt = u.pn * BM; bf16_t* base = O;
        float sc = 1.f; if (split_cols) { const int t = colt / split_cols; base += (size_t)t * split_stride; colt -= t * split_cols; if (t == 0) sc = scale0; }
        const int col0 = colt + wc * 32 + 8 * fq, bcol0 = u.pn * BM + wc * 32 + 8 * fq;
        f32x4 bv[2][2];
#pragma unroll
        for (int bj = 0; bj < 2; ++bj)
#pragma unroll
            for (int n = 0; n < 2; ++n) bv[bj][n] = bias ? *(const f32x4*)(bias + bcol0 + bj * HALF + 4 * n) : (f32x4){0.f, 0.f, 0.f, 0.f};
#pragma unroll
        for (int ai = 0; ai < 2; ++ai)
#pragma unroll
            for (int m = 0; m < 4; ++m) { bf16_t* rowp = base + (size_t)(row0 + ai * HALF + m * 16) * ldc + col0;
#pragma unroll
                for (int bj = 0; bj < 2; ++bj) { f32x4 v0 = acc[ai][bj][m][0] + bv[bj][0], v1 = acc[ai][bj][m][1] + bv[bj][1];
                    if (ACT == 1) { f32x2 a = gelu_pk((f32x2){v0[0], v0[1]}), b = gelu_pk((f32x2){v0[2], v0[3]}), c = gelu_pk((f32x2){v1[0], v1[1]}), d = gelu_pk((f32x2){v1[2], v1[3]});
                        v0 = (f32x4){a.x, a.y, b.x, b.y}; v1 = (f32x4){c.x, c.y, d.x, d.y}; }
                    v0 = v0 * sc; v1 = v1 * sc; u32x4 w; w.x = cvt_pk_bf16(v0[0], v0[1]); w.y = cvt_pk_bf16(v0[2], v0[3]); w.z = cvt_pk_bf16(v1[0], v1[1]); w.w = cvt_pk_bf16(v1[2], v1[3]);
                    *(u32x4*)(rowp + bj * HALF) = w; } }
    }
};

struct PanelStats {
    unsigned* xbuf;
    unsigned* cnt;
    unsigned* tmo;
    int ntn; float eps;
    unsigned code;
    __device__ __forceinline__ bool run(const f32x4 (&v)[2][2][4][2], const Unit& u, int wr, int wc, int fr, int fq, PG8_LAS unsigned char* lds, int wid, int lane) const {
        typedef float f32x2v __attribute__((ext_vector_type(2)));
        PG8_LAS f32x2v* P = (PG8_LAS f32x2v*)lds;
        PG8_LAS f32x2v* S = (PG8_LAS f32x2v*)(lds + 8192);
        PG8_LAS unsigned* flag = (PG8_LAS unsigned*)(lds + 8192 + 2048);
#pragma unroll
        for (int ai = 0; ai < 2; ++ai)
#pragma unroll
            for (int m = 0; m < 4; ++m) {
                float s = 0.f;
#pragma unroll
                for (int bj = 0; bj < 2; ++bj)
#pragma unroll
                    for (int n = 0; n < 2; ++n) { const f32x4 x = v[ai][bj][m][n]; s += (x[0] + x[1]) + (x[2] + x[3]); }
                s += __shfl_xor(s, 16); s += __shfl_xor(s, 32);
                const float mw = s * (1.0f / 64.0f); float q = 0.f;
#pragma unroll
                for (int bj = 0; bj < 2; ++bj)
#pragma unroll
                    for (int n = 0; n < 2; ++n) { const f32x4 d = v[ai][bj][m][n] - mw; q += (d[0] * d[0] + d[1] * d[1]) + (d[2] * d[2] + d[3] * d[3]); }
                q += __shfl_xor(q, 16); q += __shfl_xor(q, 32);
                if (fq == 0) P[(ai * HALF + wr * 64 + m * 16 + fr) * 4 + wc] = (f32x2v){mw, q};
            }
        asm volatile("s_waitcnt lgkmcnt(0)" ::: "memory"); __builtin_amdgcn_s_barrier(); asm volatile("" ::: "memory");
#if defined(BROKEN_EXCHANGE_NO_WAIT)
#warning BROKEN CONTROL BUILD: the row-statistics exchange does not wait; results are wrong by design
        if (blockIdx.x >= 64) { const long long t0_ = clock64(); while (clock64() - t0_ < 60000) __builtin_amdgcn_s_sleep(8); }
#endif
        const int row = wid * 32 + (lane & 31);
        if (lane < 32) {
            const f32x2v a = P[row * 4 + 0], b = P[row * 4 + 1], c = P[row * 4 + 2], d = P[row * 4 + 3];
            const float mt = (a.x + b.x + c.x + d.x) * 0.25f;
            const float da = a.x - mt, db = b.x - mt, dc = c.x - mt, dd = d.x - mt;
            const float m2 = (a.y + b.y) + (c.y + d.y) + 64.0f * ((da * da + db * db) + (dc * dc + dd * dd));
            unsigned long long* slot = (unsigned long long*)xbuf + ((size_t)(u.pm * BM + row) * 4 + u.pn);
            __hip_atomic_store(slot, ((unsigned long long)__float_as_uint(m2) << 32) | __float_as_uint(mt), __ATOMIC_RELAXED, __HIP_MEMORY_SCOPE_AGENT);
        }
        asm volatile("s_waitcnt vmcnt(0)" ::: "memory");
        if (lane == 0) __hip_atomic_fetch_add(cnt + 64 * u.pm, 1u, __ATOMIC_RELAXED, __HIP_MEMORY_SCOPE_AGENT);
        if (wid == 0) {
            bool dead = false; const unsigned long long t0 = __builtin_amdgcn_s_memrealtime(); const unsigned want = 8u * (unsigned)ntn;
            for (;;) {
#if defined(BROKEN_EXCHANGE_NO_WAIT)
                break;
#endif
                if ((unsigned)__builtin_amdgcn_readfirstlane(__hip_atomic_load(cnt + 64 * u.pm, __ATOMIC_RELAXED, __HIP_MEMORY_SCOPE_AGENT)) >= want) break;
                if (__builtin_amdgcn_s_memrealtime() - t0 > 2000000ull) {
                    if (lane == 0) { unsigned expect = 0u; __hip_atomic_compare_exchange_strong(tmo + 1, &expect, code | (unsigned)(u.pm & 0xff), __ATOMIC_RELAXED, __ATOMIC_RELAXED, __HIP_MEMORY_SCOPE_AGENT);
                                     __hip_atomic_store(tmo, 1u, __ATOMIC_RELAXED, __HIP_MEMORY_SCOPE_AGENT); }
                    dead = true; break; }
                __builtin_amdgcn_s_sleep(2);
            }
            __builtin_amdgcn_fence(__ATOMIC_ACQUIRE, "agent");
            if (lane == 0) flag[0] = dead ? 1u : 0u;
        }
        asm volatile("s_waitcnt vmcnt(0) lgkmcnt(0)" ::: "memory"); __builtin_amdgcn_s_barrier(); asm volatile("" ::: "memory");
        const bool bad = flag[0] != 0u;
        if (lane < 32) {
            const unsigned long long* slot = (const unsigned long long*)xbuf + (size_t)(u.pm * BM + row) * 4; float mt[4], m2[4]; float ms = 0.f;
#pragma unroll
            for (int t = 0; t < 4; ++t) { if (t < ntn) { const unsigned long long w = __hip_atomic_load(slot + t, __ATOMIC_RELAXED, __HIP_MEMORY_SCOPE_AGENT); mt[t] = __uint_as_float((unsigned)w); m2[t] = __uint_as_float((unsigned)(w >> 32)); } else { mt[t] = 0.f; m2[t] = 0.f; } ms += mt[t]; }
            const float mean = ms / (float)ntn; float q = 0.f;
#pragma unroll
            for (int t = 0; t < 4; ++t) if (t < ntn) { const float dm = mt[t] - mean; q += m2[t] + 256.0f * dm * dm; }
            S[row] = (f32x2v){mean, 1.0f / sqrtf(q / (256.0f * (float)ntn) + eps)};
        }
        asm volatile("s_waitcnt lgkmcnt(0)" ::: "memory"); __builtin_amdgcn_s_barrier(); asm volatile("" ::: "memory");
        return bad;
    }
};
struct EpiLnRes {
    static constexpr bool PERM = false, AFTER_DRAIN = true;
    const float* base; float* out; int ldc; const float* bias; PanelStats st; unsigned poison;
    __device__ __forceinline__ void fused(f32x4 (&acc)[2][2][4][2], const Unit& u, int wr, int wc, int fr, int fq, PG8_LAS unsigned char* lds, int wid, int lane) const {
        typedef float f32x2v __attribute__((ext_vector_type(2)));
        const PG8_LAS f32x2v* S = (const PG8_LAS f32x2v*)(lds + 8192);
        const int col0 = u.pn * BM + wc * 32 + 4 * fq;
#pragma unroll
        for (int bj = 0; bj < 2; ++bj)
#pragma unroll
            for (int n = 0; n < 2; ++n) { const f32x4 bv = bias ? *(const f32x4*)(bias + col0 + bj * HALF + n * 16) : (f32x4){0.f, 0.f, 0.f, 0.f};
#pragma unroll
                for (int ai = 0; ai < 2; ++ai)
#pragma unroll
                    for (int m = 0; m < 4; ++m) acc[ai][bj][m][n] += bv; }
        f32x4 pre[4][2][2];
#pragma unroll
        for (int m = 0; m < 4; ++m) { const size_t off = (size_t)(u.pm * BM + wr * 64 + m * 16 + fr) * ldc + col0;
#pragma unroll
            for (int bj = 0; bj < 2; ++bj)
#pragma unroll
                for (int n = 0; n < 2; ++n) pre[m][bj][n] = *(const f32x4*)(base + off + bj * HALF + n * 16); }
        const bool bad = st.run(acc, u, wr, wc, fr, fq, lds, wid, lane) || poison != 0u;
        const float qnan = __builtin_nanf("");
#pragma unroll
        for (int ai = 0; ai < 2; ++ai)
#pragma unroll
            for (int m = 0; m < 4; ++m) { const int r = ai * HALF + wr * 64 + m * 16 + fr; const f32x2v sr = S[r]; const size_t off = (size_t)(u.pm * BM + r) * ldc + col0;
#pragma unroll
                for (int bj = 0; bj < 2; ++bj)
#pragma unroll
                    for (int n = 0; n < 2; ++n) { const f32x4 bs = ai == 0 ? pre[m][bj][n] : *(const f32x4*)(base + off + bj * HALF + n * 16); f32x4 o = bs + (acc[ai][bj][m][n] - sr.x) * sr.y;
                        if (bad) o = (f32x4){qnan, qnan, qnan, qnan}; *(f32x4*)(out + off + bj * HALF + n * 16) = o; }
                if (m & 1) asm volatile("" ::: "memory"); }
    }
};
struct EpiLnResLn {
    static constexpr bool PERM = false, AFTER_DRAIN = true;
    const float* base; float* out; bf16_t* xn; int ldc; const float* bias; PanelStats st1, st2; unsigned poison;
    __device__ __forceinline__ void fused(f32x4 (&acc)[2][2][4][2], const Unit& u, int wr, int wc, int fr, int fq, PG8_LAS unsigned char* lds, int wid, int lane) const {
        typedef float f32x2v __attribute__((ext_vector_type(2))); typedef unsigned u32x2v __attribute__((ext_vector_type(2)));
        const PG8_LAS f32x2v* S = (const PG8_LAS f32x2v*)(lds + 8192);
        const int col0 = u.pn * BM + wc * 32 + 4 * fq;
#pragma unroll
        for (int bj = 0; bj < 2; ++bj)
#pragma unroll
            for (int n = 0; n < 2; ++n) { const f32x4 bv = bias ? *(const f32x4*)(bias + col0 + bj * HALF + n * 16) : (f32x4){0.f, 0.f, 0.f, 0.f};
#pragma unroll
                for (int ai = 0; ai < 2; ++ai)
#pragma unroll
                    for (int m = 0; m < 4; ++m) acc[ai][bj][m][n] += bv; }
        bool bad = st1.run(acc, u, wr, wc, fr, fq, lds, wid, lane) || poison != 0u;
        const float qnan = __builtin_nanf("");
#pragma unroll
        for (int ai = 0; ai < 2; ++ai)
#pragma unroll
            for (int m = 0; m < 4; ++m) { const int r = ai * HALF + wr * 64 + m * 16 + fr; const f32x2v sr = S[r]; const size_t off = (size_t)(u.pm * BM + r) * ldc + col0;
#pragma unroll
                for (int bj = 0; bj < 2; ++bj)
#pragma unroll
                    for (int n = 0; n < 2; ++n) { const f32x4 bs = *(const f32x4*)(base + off + bj * HALF + n * 16); acc[ai][bj][m][n] = bs + (acc[ai][bj][m][n] - sr.x) * sr.y; }
                asm volatile("" : "+v"(acc[ai][0][m][0]), "+v"(acc[ai][0][m][1]), "+v"(acc[ai][1][m][0]), "+v"(acc[ai][1][m][1]));
                if (m & 1) asm volatile("" ::: "memory"); }
        const bool bad1 = bad;
        bad = st2.run(acc, u, wr, wc, fr, fq, lds, wid, lane) || bad;
#pragma unroll
        for (int ai = 0; ai < 2; ++ai)
#pragma unroll
            for (int m = 0; m < 4; ++m) { const int r = ai * HALF + wr * 64 + m * 16 + fr; const f32x2v sr = S[r]; const size_t off = (size_t)(u.pm * BM + r) * ldc + col0;
#pragma unroll
                for (int bj = 0; bj < 2; ++bj)
#pragma unroll
                    for (int n = 0; n < 2; ++n) { const f32x4 x1 = acc[ai][bj][m][n]; *(f32x4*)(out + off + bj * HALF + n * 16) = bad1 ? (f32x4){qnan, qnan, qnan, qnan} : x1;
                        const f32x4 o = (x1 - sr.x) * sr.y; u32x2v w; w.x = cvt_pk_bf16(o[0], o[1]); w.y = cvt_pk_bf16(o[2], o[3]);
                        if (bad) { w.x = 0x7fc07fc0u; w.y = 0x7fc07fc0u; } *(u32x2v*)(xn + off + bj * HALF + n * 16) = w; }
                asm volatile("" ::: "memory"); }
    }
};

template <class Epi, class Sched, bool ALIGN_EPI = false, bool SP2 = false>
__device__ __forceinline__ void gemm_phase(PG8_LAS unsigned char* lds, const Gemm g, const Sched& S, const Epi& E) {
    int tid_ = threadIdx.x; asm volatile("" : "+v"(tid_));
    const int tid = tid_, wid = __builtin_amdgcn_readfirstlane(tid >> 6), lane = tid & 63, wr = wid >> 2, wc = wid & 3, fr = lane & 15, fq = lane >> 4;
    const int K = g.K, nt = K / BK;
    unsigned voffA[2], voffB[2];
#pragma unroll
    for (int i = 0; i < 2; ++i) { int R, C; stage_rc(tid * 16 + i * 8192, R, C); const int Rb = Epi::PERM ? ((R & ~31) + perm32(R & 31)) : R;
        voffA[i] = (unsigned)(R * K + C) * 2u; voffB[i] = (unsigned)(Rb * K + C) * 2u; }
    const size_t kstep = (size_t)(BK * 2);
    const size_t hstep = (size_t)HALF * K * 2;
    const size_t tstep = 2 * hstep;
    const unsigned ldsw = (unsigned)wid * 1024u;
    const int aoff = lds_byte(wr * 64 + fr, fq * 8), boff = lds_byte(wc * 32 + fr, fq * 8);
#define PG8_SA(b, h) (((b) * 2 + (h)) * HTB)
#define PG8_SB(b, h) ((4 + (b) * 2 + (h)) * HTB)
#define PG8_STAGE(bufoff, gbase, voff) do { _Pragma("unroll") for (int _i = 0; _i < 2; ++_i) \
        __builtin_amdgcn_global_load_lds((const unsigned*)((const char*)(gbase) + (voff)[_i]), (PG8_LAS unsigned*)(lds + (bufoff) + ldsw + _i * 8192), 16, 0, 0); } while (0)
#define PG8_LDA(dst, b, h) do { _Pragma("unroll") for (int m = 0; m < 4; ++m) _Pragma("unroll") for (int k = 0; k < 2; ++k) dst[m][k] = *(const PG8_LAS bf16x8*)(lds + PG8_SA(b, h) + aoff + m * 2048 + k * 1024); } while (0)
#define PG8_LDB(dst, b, h) do { _Pragma("unroll") for (int n = 0; n < 2; ++n) _Pragma("unroll") for (int k = 0; k < 2; ++k) dst[n][k] = *(const PG8_LAS bf16x8*)(lds + PG8_SB(b, h) + boff + n * 2048 + k * 1024); } while (0)
#define PG8_MMA(ai, bj, At, Bt) do { __builtin_amdgcn_s_setprio(1); _Pragma("unroll") for (int m = 0; m < 4; ++m) _Pragma("unroll") for (int n = 0; n < 2; ++n) _Pragma("unroll") for (int k = 0; k < 2; ++k) \
        acc[ai][bj][m][n] = __builtin_amdgcn_mfma_f32_16x16x32_bf16(Bt[n][k], At[m][k], acc[ai][bj][m][n], 0, 0, 0); __builtin_amdgcn_s_setprio(0); } while (0)
#define PG8_WAIT_V(n) asm volatile("s_waitcnt vmcnt(" #n ")" ::: "memory")
#define PG8_WAIT_L(n) asm volatile("s_waitcnt lgkmcnt(" #n ")" ::: "memory")
#define PG8_BAR __builtin_amdgcn_s_barrier()
#define PG8_SCHED __builtin_amdgcn_sched_barrier(0)
    Unit cur, nxt; int ui = 0;
    if (!S.next(0, cur)) return;
    f32x4 acc[2][2][4][2];
#pragma unroll
    for (int a = 0; a < 2; ++a)
#pragma unroll
        for (int b = 0; b < 2; ++b)
#pragma unroll
            for (int m = 0; m < 4; ++m)
#pragma unroll
                for (int n = 0; n < 2; ++n) acc[a][b][m][n] = (f32x4){0.f, 0.f, 0.f, 0.f};
    bf16x8 At[4][2], B0[2][2], B1[2][2];
    const char* cA = (const char*)g.A + (size_t)cur.pm * tstep; const char* cB = (const char*)g.Bt + (size_t)cur.pn * tstep;
    S.a_ready(cur);
    if constexpr (SP2) {
        PG8_STAGE(PG8_SB(0, 0), cB, voffB); PG8_STAGE(PG8_SB(0, 1), cB + hstep, voffB); PG8_STAGE(PG8_SA(0, 0), cA, voffA); PG8_STAGE(PG8_SA(0, 1), cA + hstep, voffA);
        if (wr == 1) PG8_BAR;
        PG8_WAIT_V(2); PG8_BAR;
        PG8_STAGE(PG8_SB(1, 0), cB + kstep, voffB); PG8_STAGE(PG8_SA(1, 0), cA + kstep, voffA); PG8_STAGE(PG8_SB(1, 1), cB + hstep + kstep, voffB);
        PG8_WAIT_V(6); PG8_BAR;
    } else {
        PG8_STAGE(PG8_SB(0, 0), cB, voffB); PG8_STAGE(PG8_SA(0, 0), cA, voffA); PG8_STAGE(PG8_SB(0, 1), cB + hstep, voffB); PG8_STAGE(PG8_SA(0, 1), cA + hstep, voffA);
        if (wr == 1) PG8_BAR;
        PG8_WAIT_V(4); PG8_BAR;
        PG8_STAGE(PG8_SB(1, 0), cB + kstep, voffB); PG8_STAGE(PG8_SA(1, 0), cA + kstep, voffA); PG8_STAGE(PG8_SB(1, 1), cB + hstep + kstep, voffB);
        PG8_WAIT_V(6); PG8_BAR;
    }
    for (;;) {
        const bool has_next = S.next(ui + 1, nxt);
        const char* nA = has_next ? (const char*)g.A + (size_t)nxt.pm * tstep : cA; const char* nB = has_next ? (const char*)g.Bt + (size_t)nxt.pn * tstep : cB;
        for (int t = 0; t < nt; t += 2) {
            const bool last = (t == nt - 2);
            const char* a1 = cA + (size_t)(t + 1) * kstep;
            const char* a2 = last ? nA : cA + (size_t)(t + 2) * kstep; const char* b2 = last ? nB : cB + (size_t)(t + 2) * kstep;
            const char* a3 = a2 + kstep; const char* b3 = b2 + kstep;
            if (last && has_next) S.a_ready(nxt);
            if constexpr (SP2) {
            PG8_LDB(B0, 0, 0); PG8_LDB(B1, 0, 1); PG8_SCHED; PG8_LDA(At, 0, 0); PG8_STAGE(PG8_SA(1, 1), a1 + hstep, voffA);
            PG8_WAIT_V(8); PG8_WAIT_L(0); PG8_BAR; PG8_MMA(0, 0, At, B0); PG8_MMA(0, 1, At, B1); PG8_BAR; PG8_SCHED;
            PG8_LDA(At, 0, 1); PG8_STAGE(PG8_SB(0, 0), b2, voffB); PG8_STAGE(PG8_SB(0, 1), b2 + hstep, voffB); PG8_STAGE(PG8_SA(0, 0), a2, voffA);
            PG8_WAIT_V(8); PG8_WAIT_L(0); PG8_BAR; PG8_MMA(1, 0, At, B0); PG8_MMA(1, 1, At, B1); PG8_BAR; PG8_SCHED;
            PG8_LDB(B0, 1, 0); PG8_LDB(B1, 1, 1); PG8_SCHED; PG8_LDA(At, 1, 0); PG8_STAGE(PG8_SA(0, 1), a2 + hstep, voffA);
            PG8_WAIT_V(8); PG8_WAIT_L(0); PG8_BAR; PG8_MMA(0, 0, At, B0); PG8_MMA(0, 1, At, B1); PG8_BAR; PG8_SCHED;
            PG8_LDA(At, 1, 1); PG8_STAGE(PG8_SB(1, 0), b3, voffB); PG8_STAGE(PG8_SB(1, 1), b3 + hstep, voffB); PG8_STAGE(PG8_SA(1, 0), a3, voffA);
            PG8_WAIT_V(8); PG8_WAIT_L(0); PG8_BAR; PG8_MMA(1, 0, At, B0); PG8_MMA(1, 1, At, B1); PG8_BAR; PG8_SCHED;
            } else {
            PG8_LDB(B0, 0, 0); PG8_SCHED; PG8_LDA(At, 0, 0); PG8_STAGE(PG8_SA(1, 1), a1 + hstep, voffA);
            PG8_WAIT_L(8); PG8_BAR; PG8_WAIT_L(0); PG8_MMA(0, 0, At, B0); PG8_BAR; PG8_SCHED;
            PG8_LDB(B1, 0, 1); PG8_STAGE(PG8_SB(0, 0), b2, voffB);
            PG8_BAR; PG8_WAIT_L(0); PG8_MMA(0, 1, At, B1); PG8_BAR;
            PG8_LDA(At, 0, 1); PG8_STAGE(PG8_SA(0, 0), a2, voffA);
            PG8_BAR; PG8_WAIT_L(0); PG8_MMA(1, 0, At, B0); PG8_BAR; PG8_SCHED;
            PG8_STAGE(PG8_SB(0, 1), b2 + hstep, voffB);
            PG8_WAIT_V(6); PG8_BAR; PG8_MMA(1, 1, At, B1); PG8_BAR;
            PG8_LDB(B0, 1, 0); PG8_SCHED; PG8_LDA(At, 1, 0); PG8_STAGE(PG8_SA(0, 1), a2 + hstep, voffA);
            PG8_WAIT_L(8); PG8_BAR; PG8_WAIT_L(0); PG8_MMA(0, 0, At, B0); PG8_BAR; PG8_SCHED;
            PG8_LDB(B1, 1, 1); PG8_STAGE(PG8_SB(1, 0), b3, voffB);
            PG8_BAR; PG8_WAIT_L(0); PG8_MMA(0, 1, At, B1); PG8_BAR;
            PG8_LDA(At, 1, 1); PG8_STAGE(PG8_SA(1, 0), a3, voffA);
            PG8_BAR; PG8_WAIT_L(0); PG8_MMA(1, 0, At, B0); PG8_BAR; PG8_SCHED;
            PG8_STAGE(PG8_SB(1, 1), b3 + hstep, voffB);
            PG8_WAIT_V(6); PG8_BAR; PG8_MMA(1, 1, At, B1); PG8_BAR;
            }
        }
        if constexpr (ALIGN_EPI) { if (wr == 0) PG8_BAR; }
        if constexpr (!Epi::AFTER_DRAIN) { E(acc, cur, wr, wc, fr, fq); S.done(cur); }
        if (!has_next) break;
#pragma unroll
        for (int a = 0; a < 2; ++a)
#pragma unroll
            for (int b = 0; b < 2; ++b)
#pragma unroll
                for (int m = 0; m < 4; ++m)
#pragma unroll
                    for (int n = 0; n < 2; ++n) acc[a][b][m][n] = (f32x4){0.f, 0.f, 0.f, 0.f};
        cur = nxt; cA = nA; cB = nB; ++ui;
        if constexpr (ALIGN_EPI) { if (wr == 1) PG8_BAR; }
    }
    PG8_WAIT_V(0);
    if constexpr (!ALIGN_EPI) { if (wr == 0) PG8_BAR; }
    PG8_BAR;
    if constexpr (Epi::AFTER_DRAIN) { E.fused(acc, cur, wr, wc, fr, fq, lds, wid, lane); S.done(cur); }
#undef PG8_SA
#undef PG8_SB
#undef PG8_STAGE
#undef PG8_LDA
#undef PG8_LDB
#undef PG8_MMA
#undef PG8_WAIT_V
#undef PG8_WAIT_L
#undef PG8_BAR
#undef PG8_SCHED
}
}
namespace attn_body {
using bf16=__hip_bfloat16;
using bf16x8=__attribute__((ext_vector_type(8)))short;
using s16x4=__attribute__((ext_vector_type(4)))short;
using f32x16=__attribute__((ext_vector_type(16)))float;
using u32x4=__attribute__((ext_vector_type(4)))unsigned;
constexpr int BATCH=2,NHEAD=8,SEQ=8192,D=64,DM=NHEAD*D;
constexpr int NW=8,QBLK=32,QB=QBLK*NW,KVBLK=64,NQB=SEQ/QB;
constexpr int ATTN_PITCH=DM, ATTN_UNIT_ROWS=QB, LFT_PITCH=16640;
__device__ __forceinline__ int crow(int r,int hi){return (r&3)+8*(r>>2)+4*hi;}
#define SBAR() __builtin_amdgcn_sched_barrier(0)
__device__ __forceinline__ void cmask(f32x16&p0,f32x16&p1,int jb,int qrel,int hi){
  const float NEG=-INFINITY; int kb=64*jb+4*hi;
  #pragma unroll
  for(int r=0;r<16;++r){int kv=kb+(r&3)+8*(r>>2); if(kv>qrel)p0[r]=NEG; if(kv+32>qrel)p1[r]=NEG;}
}

constexpr int NSLOT=3, SLOTB=8192;
constexpr int LDS_K=0, LDS_V=NSLOT*SLOTB, LDS_WS=2*NSLOT*SLOTB, LDS_OST=LDS_WS+NW*64*4, LDS_KB=LDS_OST+NW*4096, LDS_BYTES=LDS_KB+SEQ*4;
constexpr float C2=0.125f*1.4426950408889634f;
__device__ __forceinline__ void glds16(const void*gsrc,unsigned lds_dst){unsigned keep;
  asm volatile("s_mov_b32 %0, m0\n\ts_mov_b32 m0, %2\n\ts_nop 0\n\tglobal_load_lds_dwordx4 %1, off\n\ts_mov_b32 m0, %0":"=&s"(keep):"v"(gsrc),"s"(lds_dst):"memory");}
__device__ __forceinline__ float max3f(float a,float b,float c){float r;asm("v_max3_f32 %0, %1, %2, %3":"=v"(r):"v"(a),"v"(b),"v"(c));return r;}
__device__ __forceinline__ float max2f(float a,float b){float r;asm("v_max_f32_e32 %0, %1, %2":"=v"(r):"v"(a),"v"(b));return r;}
__device__ __forceinline__ float fadd_s(float a,float b){float r;asm("v_add_f32_e32 %0, %1, %2":"=v"(r):"v"(a),"v"(b));return r;}
__device__ __forceinline__ float fsub_s(float a,float b){float r;asm("v_sub_f32_e32 %0, %1, %2":"=v"(r):"v"(a),"v"(b));return r;}
typedef float f32x2_t __attribute__((ext_vector_type(2))); typedef __bf16 bf16x2_t __attribute__((ext_vector_type(2)));
__device__ __forceinline__ unsigned cvtpk_s(float lo,float hi){f32x2_t v={lo,hi};bf16x2_t b=__builtin_convertvector(v,bf16x2_t);return __builtin_bit_cast(unsigned,b);}
#define WAIT_BAR(N) asm volatile("s_waitcnt vmcnt(" #N ") lgkmcnt(0)\n\ts_barrier":::"memory")

__device__ __forceinline__ void qkt(f32x16&p0,f32x16&p1,const char*Kslot,const bf16x8*qr,const f32x16&negm,int r32,int hi){
  const char*kb=Kslot+hi*1024+r32*16;
  #pragma unroll
  for(int d0=0;d0<4;++d0){
    const bf16x8 b0=*reinterpret_cast<const bf16x8*>(kb+d0*2048);
    const bf16x8 b1=*reinterpret_cast<const bf16x8*>(kb+d0*2048+512);
    p0=__builtin_amdgcn_mfma_f32_32x32x16_bf16(b0,qr[d0],p0,0,0,0);p1=__builtin_amdgcn_mfma_f32_32x32x16_bf16(b1,qr[d0],p1,0,0,0);}
}
typedef __attribute__((address_space(3))) const char* lds_cptr;
typedef short v4i16_t __attribute__((ext_vector_type(4)));
__device__ __forceinline__ void kload8(bf16x8*kf,lds_cptr kp){
  kf[0]=*(const __attribute__((address_space(3))) bf16x8*)(kp);      kf[1]=*(const __attribute__((address_space(3))) bf16x8*)(kp+512);
  kf[2]=*(const __attribute__((address_space(3))) bf16x8*)(kp+2048); kf[3]=*(const __attribute__((address_space(3))) bf16x8*)(kp+2560);
  kf[4]=*(const __attribute__((address_space(3))) bf16x8*)(kp+4096); kf[5]=*(const __attribute__((address_space(3))) bf16x8*)(kp+4608);
  kf[6]=*(const __attribute__((address_space(3))) bf16x8*)(kp+6144); kf[7]=*(const __attribute__((address_space(3))) bf16x8*)(kp+6656);
}
__device__ __forceinline__ void kload2(bf16x8*kf,lds_cptr kp,int j){ kf[2*j]=*(const __attribute__((address_space(3))) bf16x8*)(kp+j*2048); kf[2*j+1]=*(const __attribute__((address_space(3))) bf16x8*)(kp+j*2048+512); }
__device__ __forceinline__ s16x4 vtr(lds_cptr p){ return __builtin_bit_cast(s16x4,__builtin_amdgcn_ds_read_tr16_b64_v4i16((__attribute__((address_space(3))) v4i16_t*)p)); }
__device__ __forceinline__ float rowmax(const f32x16&p0,const f32x16&p1){
  float a=max3f(p0[0],p0[1],p1[0]),b=max3f(p0[2],p0[3],p1[1]);a=max3f(a,p1[2],p1[3]);
  #pragma unroll
  for(int r=4;r<16;r+=4){a=max3f(a,p0[r],p0[r+1]);b=max3f(b,p0[r+2],p0[r+3]);a=max3f(a,p1[r],p1[r+1]);b=max3f(b,p1[r+2],p1[r+3]);}
  const float m=max2f(a,b);
  auto rr=__builtin_amdgcn_permlane32_swap(__float_as_uint(m),__float_as_uint(m),false,false);
  return max2f(__uint_as_float(rr[0]),__uint_as_float(rr[1]));
}
__device__ __forceinline__ void pv(f32x16*o,int vb,bf16x8 pa0,bf16x8 pa1,bf16x8 pa2,bf16x8 pa3){
  #pragma unroll
  for(int d0=0;d0<2;++d0){s16x4 lo[4],hi[4];
    #pragma unroll
    for(int ks=0;ks<4;++ks){
      asm volatile("ds_read_b64_tr_b16 %0,%1 offset:%c2":"=&v"(lo[ks]):"v"(vb),"i"(d0*4096+ks*1024):"memory");
      asm volatile("ds_read_b64_tr_b16 %0,%1 offset:%c2":"=&v"(hi[ks]):"v"(vb),"i"(d0*4096+ks*1024+512):"memory");}
    asm volatile("s_waitcnt lgkmcnt(0)":::"memory");SBAR();
    #define PK(k) (bf16x8){lo[k][0],lo[k][1],lo[k][2],lo[k][3],hi[k][0],hi[k][1],hi[k][2],hi[k][3]}
    o[d0]=__builtin_amdgcn_mfma_f32_32x32x16_bf16(pa0,PK(0),o[d0],0,0,0);
    o[d0]=__builtin_amdgcn_mfma_f32_32x32x16_bf16(pa1,PK(1),o[d0],0,0,0);
    o[d0]=__builtin_amdgcn_mfma_f32_32x32x16_bf16(pa2,PK(2),o[d0],0,0,0);
    o[d0]=__builtin_amdgcn_mfma_f32_32x32x16_bf16(pa3,PK(3),o[d0],0,0,0);
    #undef PK
  }
}

#ifndef ATTN_STORE16
#define ATTN_STORE16(p,v) (*(u32x4*)(p)=(v))
#endif
template<int THRL> __device__ __forceinline__ void attn_unit(int b,int h,int qb,const bf16*Q,const bf16*__restrict__ K,const bf16*__restrict__ V,bf16*O,const float*LFT,char*shm){
  int tid_l=threadIdx.x; asm volatile("":"+v"(tid_l)); const int tid=tid_l,lane=tid&63,r32=lane&31,hi=lane>>5; const int wid=__builtin_amdgcn_readfirstlane(tid>>6);
  const long rowbase=(long)b*SEQ; const int q0=qb*QB;
  const bf16*Qw=Q+(rowbase+q0+wid*QBLK)*DM+h*D;
  const bf16*Kh=K+rowbase*DM+h*D,*Vh=V+rowbase*DM+h*D;
  const lds_cptr shm3=(lds_cptr)shm;
  const unsigned lds0=(unsigned)(uintptr_t)shm;
  float*wsf=(float*)(shm+LDS_WS)+wid*64;
  const bf16*ksrc=Kh+(long)lane*DM+wid*8;
  const bf16*vsrc=Vh+(long)(16*(wid&3)+(lane>>2))*DM+(wid>>2)*32+(lane&3)*8;
  const unsigned kdst=lds0+LDS_K+wid*1024, vdst=lds0+LDS_V+wid*1024;
  #define DMA_K(t,slot) glds16(ksrc+(long)(t)*KVBLK*DM,(unsigned)__builtin_amdgcn_readfirstlane(kdst+(slot)))
  #define DMA_V(t,slot) glds16(vsrc+(long)(t)*KVBLK*DM,(unsigned)__builtin_amdgcn_readfirstlane(vdst+(slot)))
  const int vb0=(int)(lds0+LDS_V)+((lane>>4)&1)*32+(lane&3)*8+(4*hi+((lane&15)>>2))*64;
  const char*Kbase=shm+LDS_K; bf16x8 kf[8];
  const lds_cptr kp0=shm3+LDS_K+hi*1024+r32*16; const lds_cptr vp0=shm3+LDS_V+((lane>>4)&1)*32+(lane&3)*8+(4*hi+((lane&15)>>2))*64;
  const int NT=(q0+QB)/KVBLK;
  { typedef float f32x4_t __attribute__((ext_vector_type(4)));
    const int n=q0+QB; const float*lf=LFT+(long)h*LFT_PITCH+rowbase; const int base=16*tid;
    __attribute__((address_space(3))) float*kbw=(__attribute__((address_space(3))) float*)(shm3+LDS_KB);
    __attribute__((address_space(3))) float*wsum=(__attribute__((address_space(3))) float*)(shm3+LDS_WS);
    float v[16]; float tot=0.f;
    if(base<n){ const f32x4_t*p=(const f32x4_t*)(lf+n-16-base);
      const f32x4_t a0=p[0],a1=p[1],a2=p[2],a3=p[3];
      v[0]=a3[3];v[1]=a3[2];v[2]=a3[1];v[3]=a3[0];v[4]=a2[3];v[5]=a2[2];v[6]=a2[1];v[7]=a2[0];v[8]=a1[3];v[9]=a1[2];v[10]=a1[1];v[11]=a1[0];v[12]=a0[3];v[13]=a0[2];v[14]=a0[1];v[15]=a0[0];
      #pragma unroll
      for(int k=0;k<16;++k)tot+=v[k]; }
    else{
      #pragma unroll
      for(int k=0;k<16;++k)v[k]=0.f; }
    float inc=tot;
    #pragma unroll
    for(int o=1;o<64;o<<=1){ const float u=__shfl_up(inc,o); if(lane>=o)inc+=u; }
    if(lane==63)wsum[wid]=inc;
    __syncthreads();
    float pre=inc-tot;
    #pragma unroll
    for(int w=0;w<NW;++w){ const float ws_=wsum[w]; if(w<wid)pre+=ws_; }
    if(base<n){ const float L2E=1.4426950408889634f; float x[16]; float run=pre;
      #pragma unroll
      for(int k=0;k<16;++k){ x[k]=run*L2E; run+=v[k]; }
      __attribute__((address_space(3))) f32x4_t*q4=(__attribute__((address_space(3))) f32x4_t*)(kbw+n-16-base);
      q4[0]=(f32x4_t){x[15],x[14],x[13],x[12]}; q4[1]=(f32x4_t){x[11],x[10],x[9],x[8]}; q4[2]=(f32x4_t){x[7],x[6],x[5],x[4]}; q4[3]=(f32x4_t){x[3],x[2],x[1],x[0]}; }
    __syncthreads();
  }
  DMA_K(0,0);DMA_V(0,0);DMA_K(1,SLOTB);
  bf16x8 qr[4];
  #pragma unroll
  for(int d0=0;d0<4;++d0)qr[d0]=*reinterpret_cast<const bf16x8*>(&Qw[(long)r32*DM+d0*16+hi*8]);
  float mhat=0.f,l_reg=0.f;f32x16 o[2];o[0]=f32x16{};o[1]=f32x16{};f32x16 negm=f32x16{};asm volatile("":"+v"(negm));
  const int qrel=wid*QBLK+r32;
  #define CMASK(P0,P1,t) do{int jb_=(t)-(NT-4); if(jb_>=0)cmask(P0,P1,jb_,qrel,hi);}while(0)
  bool resc=false;
  #define START(P0,P1) do{ const float rm=rowmax(P0,P1); resc=false; \
    { const float dl=rm; mhat=fadd_s(mhat,dl); \
      _Pragma("unroll") for(int r=0;r<16;++r){P0[r]=fsub_s(P0[r],dl);P1[r]=fsub_s(P1[r],dl);} \
      _Pragma("unroll") for(int r=0;r<16;++r)negm[r]=-mhat; asm volatile("":"+v"(negm)); } \
    _Pragma("unroll") for(int r=0;r<16;++r)P0[r]=__builtin_amdgcn_exp2f(P0[r]); }while(0)
  #define RESC() do{ if(resc){ asm volatile("s_waitcnt lgkmcnt(0)":::"memory"); \
      _Pragma("unroll") for(int d_=0;d_<2;++d_) _Pragma("unroll") for(int r=0;r<16;++r)o[d_][r]*=wsf[crow(r,hi)]; } }while(0)
  f32x16 pA0,pA1,pB0,pB1;
  typedef float f32x4_b __attribute__((ext_vector_type(4)));
  const __attribute__((address_space(3))) float*kbp=(const __attribute__((address_space(3))) float*)(shm3+LDS_KB)+4*hi;
  #define BLD4(X,B,off) do{ const f32x4_b b_=*(const __attribute__((address_space(3))) f32x4_b*)(kbq_+(off)); X[B]=b_[0];X[B+1]=b_[1];X[B+2]=b_[2];X[B+3]=b_[3]; }while(0)
  #define BLOAD(X0,X1,tt) do{ const __attribute__((address_space(3))) float*kbq_=kbp+(tt)*KVBLK; BLD4(X0,0,0);BLD4(X0,4,8);BLD4(X0,8,16);BLD4(X0,12,24);BLD4(X1,0,32);BLD4(X1,4,40);BLD4(X1,8,48);BLD4(X1,12,56); }while(0)
  int sl_prev=0,sl_cur=0,sl_next=SLOTB;
  #define ROT() do{sl_prev=sl_cur;sl_cur=sl_next;sl_next=(sl_next==(NSLOT-1)*SLOTB)?0:sl_next+SLOTB;}while(0)
  DMA_K(2,2*SLOTB);
  WAIT_BAR(3);
  BLOAD(pA0,pA1,0);
  qkt(pA0,pA1,Kbase,qr,negm,r32,hi);asm volatile("s_nop 15\n\ts_nop 7":"+v"(pA0),"+v"(pA1));CMASK(pA0,pA1,0);
  START(pA0,pA1);
  _Pragma("unroll") for(int r=0;r<16;++r)pA1[r]=__builtin_amdgcn_exp2f(pA1[r]);
  BLOAD(pB0,pB1,1);
  _Pragma("unroll") for(int r=0;r<16;++r){pB0[r]+=negm[r];pB1[r]+=negm[r];}
  WAIT_BAR(0);
  DMA_K(3,0);DMA_V(1,SLOTB);
  ROT();
  kload8(kf,kp0+sl_cur);
  WAIT_BAR(2);
  s16x4 vlo[8],vhi[8]; u32x4 pw0,pw1,pw2,pw3;
  #define PKW(P,B) cvtpk_s(P[B],P[B+1])
  #define PAF(k) __builtin_bit_cast(bf16x8,pw##k)
  #define VFR(i) (bf16x8){vlo[i][0],vlo[i][1],vlo[i][2],vlo[i][3],vhi[i][0],vhi[i][1],vhi[i][2],vhi[i][3]}
  #define PIN(x) asm volatile("":"+v"(x))
  #define MX3(a,b,c) __builtin_fmaxf(__builtin_fmaxf((a),(b)),(c))
  #define GAPA(MF,A0,A1,A2,A3,W0,W1,PW) do{ MF; sacc+=A0; sacc+=A1; sacc+=A2; sacc+=A3; PIN(sacc); W0; W1; PIN(PW); SBAR(); }while(0)
  #define EX(v) __builtin_amdgcn_exp2f(v)
  #define GAPB(MF,X,B,Y,GB) do{ MF; X[B]=EX(X[B]); X[B+1]=EX(X[B+1]); X[B+2]=EX(X[B+2]); X[B+3]=EX(X[B+3]); PIN(X); if(GB){ Y[B]+=negm[B]; Y[B+1]+=negm[B+1]; Y[B+2]+=negm[B+2]; Y[B+3]+=negm[B+3]; PIN(Y); } SBAR(); }while(0)
  #define VRD(i) do{ vlo[i]=vtr(vp_+(((i)>>2)*4096+((i)&3)*1024)); vhi[i]=vtr(vp_+(((i)>>2)*4096+((i)&3)*1024+512)); }while(0)
  #define KRD(G,j) do{ if(G){ kload2(kf,kp0+sl_next,j); SBAR(); } }while(0)
  #define STEP(C0,C1,P0,P1,t,GK,GV,GL,GB) do{ SBAR(); \
    const lds_cptr vp_=vp0+sl_prev; \
    VRD(0); SBAR(); float sacc=(P0[0]+P0[1]); \
    GAPA(C0=__builtin_amdgcn_mfma_f32_32x32x16_bf16(kf[0],qr[0],C0,0,0,0), P0[2],P0[3],P0[4],P0[5],     pw0[0]=PKW(P0,0), pw0[1]=PKW(P0,2), pw0); \
    VRD(4); SBAR(); GAPA(C1=__builtin_amdgcn_mfma_f32_32x32x16_bf16(kf[1],qr[0],C1,0,0,0), P0[6],P0[7],P0[8],P0[9],     pw0[2]=PKW(P0,4), pw0[3]=PKW(P0,6), pw0); \
    VRD(1); SBAR(); GAPA(C0=__builtin_amdgcn_mfma_f32_32x32x16_bf16(kf[2],qr[1],C0,0,0,0),   P0[10],P0[11],P0[12],P0[13], pw1[0]=PKW(P0,8), pw1[1]=PKW(P0,10), pw1); \
    VRD(5); SBAR(); GAPA(C1=__builtin_amdgcn_mfma_f32_32x32x16_bf16(kf[3],qr[1],C1,0,0,0),   P0[14],P0[15],P1[0],P1[1],   pw1[2]=PKW(P0,12),pw1[3]=PKW(P0,14), pw1); \
    VRD(2); SBAR(); GAPA(C0=__builtin_amdgcn_mfma_f32_32x32x16_bf16(kf[4],qr[2],C0,0,0,0),   P1[2],P1[3],P1[4],P1[5],     pw2[0]=PKW(P1,0), pw2[1]=PKW(P1,2), pw2); \
    VRD(6); SBAR(); GAPA(C1=__builtin_amdgcn_mfma_f32_32x32x16_bf16(kf[5],qr[2],C1,0,0,0),   P1[6],P1[7],P1[8],P1[9],     pw2[2]=PKW(P1,4), pw2[3]=PKW(P1,6), pw2); \
    VRD(3); SBAR(); GAPA(C0=__builtin_amdgcn_mfma_f32_32x32x16_bf16(kf[6],qr[3],C0,0,0,0),   P1[10],P1[11],P1[12],P1[13], pw3[0]=PKW(P1,8), pw3[1]=PKW(P1,10), pw3); \
    VRD(7); SBAR(); GAPA(C1=__builtin_amdgcn_mfma_f32_32x32x16_bf16(kf[7],qr[3],C1,0,0,0),   P1[14],P1[15],0.f,0.f,       pw3[2]=PKW(P1,12),pw3[3]=PKW(P1,14), pw3); \
    l_reg+=sacc; \
    if(GK){DMA_K((t)+3,sl_cur);} if(GV){DMA_V((t)+1,sl_next);} \
    CMASK(C0,C1,t); \
    { float a=MX3(C0[0],C0[1],C1[0]),b=MX3(C0[2],C0[3],C1[1]); a=MX3(a,C1[2],C1[3]); \
      _Pragma("unroll") for(int r=4;r<16;r+=4){a=MX3(a,C0[r],C0[r+1]);b=MX3(b,C0[r+2],C0[r+3]);a=MX3(a,C1[r],C1[r+1]);b=MX3(b,C1[r+2],C1[r+3]);} \
      float rm=__builtin_fmaxf(a,b); { auto rr=__builtin_amdgcn_permlane32_swap(__float_as_uint(rm),__float_as_uint(rm),false,false); rm=__builtin_fmaxf(__uint_as_float(rr[0]),__uint_as_float(rr[1])); } \
      resc=false; \
      if(__builtin_expect(__any(rm>(float)THRL),0)){ const float dl=__builtin_fmaxf(rm,0.f); mhat+=dl; \
        _Pragma("unroll") for(int r=0;r<16;++r){C0[r]-=dl;C1[r]-=dl;} \
        _Pragma("unroll") for(int r=0;r<16;++r)negm[r]=-mhat; asm volatile("":"+v"(negm)); \
        const float f=__builtin_amdgcn_exp2f(-dl); l_reg*=f; if(hi==0)wsf[r32]=f; resc=true; } } \
    if(GB){ BLOAD(P0,P1,(t)+1); } \
    SBAR(); \
    GAPB(o[0]=__builtin_amdgcn_mfma_f32_32x32x16_bf16(PAF(0),VFR(0),o[0],0,0,0), C0,0,P0,GB); \
    GAPB(o[1]=__builtin_amdgcn_mfma_f32_32x32x16_bf16(PAF(0),VFR(4),o[1],0,0,0), C0,4,P0,GB); \
    KRD(GL,0); GAPB(o[0]=__builtin_amdgcn_mfma_f32_32x32x16_bf16(PAF(1),VFR(1),o[0],0,0,0), C0,8,P0,GB); \
    KRD(GL,1); GAPB(o[1]=__builtin_amdgcn_mfma_f32_32x32x16_bf16(PAF(1),VFR(5),o[1],0,0,0), C0,12,P0,GB); \
    KRD(GL,2); GAPB(o[0]=__builtin_amdgcn_mfma_f32_32x32x16_bf16(PAF(2),VFR(2),o[0],0,0,0), C1,0,P1,GB); \
    KRD(GL,3); GAPB(o[1]=__builtin_amdgcn_mfma_f32_32x32x16_bf16(PAF(2),VFR(6),o[1],0,0,0), C1,4,P1,GB); \
    GAPB(o[0]=__builtin_amdgcn_mfma_f32_32x32x16_bf16(PAF(3),VFR(3),o[0],0,0,0), C1,8,P1,GB); \
    GAPB(o[1]=__builtin_amdgcn_mfma_f32_32x32x16_bf16(PAF(3),VFR(7),o[1],0,0,0), C1,12,P1,GB); \
    }while(0)
  int t=1;
  #undef CMASK
  #define CMASK(P0,P1,t) do{}while(0)
  for(;t+5<NT;t+=2){
    STEP(pB0,pB1,pA0,pA1,t,true,true,true,true);     WAIT_BAR(2); RESC(); ROT();
    STEP(pA0,pA1,pB0,pB1,t+1,true,true,true,true);   WAIT_BAR(2); RESC(); ROT();
  }
  #undef CMASK
  #define CMASK(P0,P1,t) do{int jb_=(t)-(NT-4); if(jb_>=0)cmask(P0,P1,jb_,qrel,hi);}while(0)
  #define ENDW(tt) do{ if((tt)+3<NT){WAIT_BAR(2);} else if((tt)+2<NT){WAIT_BAR(1);} else {WAIT_BAR(0);} }while(0)
  for(;t+1<NT;t+=2){
    STEP(pB0,pB1,pA0,pA1,t,(t+3<NT),(t+1<NT),(t+1<NT),(t+1<NT));       ENDW(t);   RESC(); ROT();
    STEP(pA0,pA1,pB0,pB1,t+1,(t+4<NT),(t+2<NT),(t+2<NT),(t+2<NT));     ENDW(t+1); RESC(); ROT();
  }
  STEP(pB0,pB1,pA0,pA1,NT-1,false,false,false,false); RESC();
  { float sacc=pB0[0]+pB0[1]; _Pragma("unroll") for(int r=2;r<16;++r)sacc+=pB0[r]; _Pragma("unroll") for(int r=0;r<16;++r)sacc+=pB1[r]; l_reg+=sacc;
    pw0=(u32x4){PKW(pB0,0),PKW(pB0,2),PKW(pB0,4),PKW(pB0,6)};pw1=(u32x4){PKW(pB0,8),PKW(pB0,10),PKW(pB0,12),PKW(pB0,14)};pw2=(u32x4){PKW(pB1,0),PKW(pB1,2),PKW(pB1,4),PKW(pB1,6)};pw3=(u32x4){PKW(pB1,8),PKW(pB1,10),PKW(pB1,12),PKW(pB1,14)};
    SBAR(); pv(o,vb0+sl_cur,PAF(0),PAF(1),PAF(2),PAF(3)); }
  #undef PKW
  #undef PAF
  #undef VFR
  #undef PIN
  #undef MX3
  #undef GAPA
  #undef GAPB
  #undef EX
  #undef VRD
  #undef KRD
  #undef STEP
  #undef ENDW
  {auto rr=__builtin_amdgcn_permlane32_swap(__float_as_uint(l_reg),__float_as_uint(l_reg),false,false);l_reg=__uint_as_float(rr[0])+__uint_as_float(rr[1]);}
  if(hi==0)wsf[32+r32]=l_reg;asm volatile("s_waitcnt lgkmcnt(0)":::"memory");
  float rli[16];
  #pragma unroll
  for(int r=0;r<16;++r)rli[r]=__builtin_amdgcn_rcpf(wsf[32+crow(r,hi)]);
  bf16*Ow=O+(rowbase+q0+wid*QBLK)*DM+h*D;
  { bf16*stg=(bf16*)(shm+LDS_OST)+wid*2048;
    #pragma unroll
    for(int r=0;r<16;++r){const int orow=crow(r,hi);
      #pragma unroll
      for(int d0=0;d0<2;++d0)stg[orow*64+d0*32+r32]=__float2bfloat16(o[d0][r]*rli[r]);}
    asm volatile("s_waitcnt lgkmcnt(0)":::"memory");
    #pragma unroll
    for(int i=0;i<4;++i){const int row=i*8+(lane>>3),ch=lane&7; const u32x4 v=*(const u32x4*)(stg+row*64+ch*8); ATTN_STORE16(Ow+(long)row*DM+ch*8,v);} }
  asm volatile("s_waitcnt lgkmcnt(0)\n\ts_barrier":::"memory");
  #undef BLD4
  #undef BLOAD
  #undef DMA_K
  #undef DMA_V
  #undef CMASK
  #undef START
  #undef RESC
  #undef ROT
}
constexpr int ATTN_LDS_BYTES=LDS_BYTES;
struct AttnTensors { const bf16* Q; const bf16* K; const bf16* V; bf16* O; const float* LFT; };
struct AttnUnit { int bh; int qb; };
struct StaticOrder {
  int vcu;
  __device__ __forceinline__ explicit StaticOrder(int grid,int block):vcu((block%8)*(grid/8)+block/8){}
  __device__ __forceinline__ bool next(int i,AttnUnit&u)const{ if(i>=2||vcu>=256)return false; const int s=vcu&15; u.bh=vcu>>4; u.qb=(i==0)?s:31-s; return true; }
  __device__ __forceinline__ void a_ready(const AttnUnit&)const{}
  __device__ __forceinline__ void done(const AttnUnit&)const{}
};
template<class Sched,int THRL=8> __device__ __forceinline__ void attn_phase(char*lds,const AttnTensors&T,const Sched&S){
  AttnUnit u;
  for(int i=0;S.next(i,u);++i){ S.a_ready(u); attn_unit<THRL>(u.bh/NHEAD,u.bh%NHEAD,u.qb,T.Q,T.K,T.V,T.O,T.LFT,lds); S.done(u); }
}
#undef SBAR
#undef WAIT_BAR
}
#define GAS __attribute__((address_space(1)))
#define LAS __attribute__((address_space(3)))
typedef unsigned short bf16;
typedef unsigned v4u __attribute__((ext_vector_type(4)));
typedef float f32x4 __attribute__((ext_vector_type(4)));
typedef short bf16x8 __attribute__((ext_vector_type(8)));
typedef GAS unsigned gu32;
typedef GAS unsigned long long gu64;
#define RLX_AGENT __ATOMIC_RELAXED, __HIP_MEMORY_SCOPE_AGENT
#define LDS_WAIT() asm volatile("s_waitcnt lgkmcnt(0)" ::: "memory")
#define VM_WAIT() asm volatile("s_waitcnt vmcnt(0)" ::: "memory")
__device__ __forceinline__ unsigned long long rt() { return __builtin_amdgcn_s_memrealtime(); }
__device__ __forceinline__ unsigned f2bf(float f) { unsigned u = __builtin_bit_cast(unsigned, f); return (u + 0x7fffu + ((u >> 16) & 1u)) >> 16; }
__device__ __forceinline__ unsigned pk2(float lo, float hi) { return f2bf(lo) | (f2bf(hi) << 16); }

#define XB_TMO      128
#define XB_XCNT(j)  (256  + 64 * (j))
#define XB_XSUB(j)  (1280 + 64 * (j))
#define XB_XGEN(j)  (2304 + 64 * (j))
#define XB_TOP      3328
#define XB_TOPGEN   3392
#define XCD_BAR_WORDS 3456
#define XB_SPIN_CAP (1u << 18)

__device__ __forceinline__ unsigned xb_ld(unsigned* p)              { return __hip_atomic_load(p, __ATOMIC_RELAXED, __HIP_MEMORY_SCOPE_AGENT); }
__device__ __forceinline__ unsigned xb_add(unsigned* p, unsigned v) { return __hip_atomic_fetch_add(p, v, __ATOMIC_RELAXED, __HIP_MEMORY_SCOPE_AGENT); }
__device__ __forceinline__ unsigned xb_xcc_id() { return (unsigned)__builtin_amdgcn_s_getreg((3 << 11) | 20) & 0xFu; }
#define XB_SPIN(cond, bar) do { unsigned _sp = 0; while (cond) { __builtin_amdgcn_s_sleep(1); \
    if ((++_sp & 255u) == 0u) { if (xb_ld(&(bar)[XB_TMO])) break; if (_sp > XB_SPIN_CAP) { atomicAdd(&(bar)[XB_TMO], 1u); break; } } } } while (0)

struct XcdBarrier {
    unsigned* bar; unsigned x;
    volatile LAS unsigned* st;
};

__device__ __forceinline__ XcdBarrier xcd_barrier_post(unsigned* bar, volatile LAS unsigned* st) {
    XcdBarrier b; b.bar = bar; b.x = xb_xcc_id(); b.st = st;
    if (threadIdx.x == 0) (void)xb_add(&bar[XB_XCNT(b.x)], 1u);
    return b;
}
__device__ __forceinline__ void xcd_barrier_complete(unsigned* bar, unsigned x, unsigned& nloc, unsigned& nx) {
    const unsigned G = gridDim.x * gridDim.y * gridDim.z;
    unsigned sum, cnt, mine, sp = 0u;
    for (;;) {
        sum = 0u; cnt = 0u; mine = 0u;
#pragma unroll
        for (unsigned j = 0; j < 16; ++j) { const unsigned c = xb_ld(&bar[XB_XCNT(j)]); sum += c; cnt += (c > 0u) ? 1u : 0u; mine = (j == x) ? c : mine; }
        if (sum == G) break;
        __builtin_amdgcn_s_sleep(1);
        if ((++sp & 255u) == 0u) { if (xb_ld(&bar[XB_TMO])) break; if (sp > XB_SPIN_CAP) { atomicAdd(&bar[XB_TMO], 1u); break; } }
    }
    nloc = mine > 0u ? mine : 1u; nx = cnt > 0u ? cnt : 1u;
}

__device__ __forceinline__ void xcd_barrier(const XcdBarrier& b) {
    asm volatile("s_waitcnt vmcnt(0)" ::: "memory");
    __syncthreads();
    if (threadIdx.x == 0) {
        unsigned* bar = b.bar;
        __builtin_amdgcn_s_waitcnt(0);
        unsigned nloc = b.st[0], nx = b.st[1];
        if (nloc == 0u) { xcd_barrier_complete(bar, b.x, nloc, nx); b.st[0] = nloc; b.st[1] = nx; }
        const unsigned old = xb_add(&bar[XB_XSUB(b.x)], 1u);
        const unsigned gen = old / nloc;
        if (old + 1u == (gen + 1u) * nloc) {
            __builtin_amdgcn_fence(__ATOMIC_RELEASE, "agent");
            asm volatile("s_waitcnt vmcnt(0)" ::: "memory");
            const unsigned og = xb_add(&bar[XB_TOP], 1u);
            const unsigned tg = og / nx;
            if (og + 1u == (tg + 1u) * nx) xb_add(&bar[XB_TOPGEN], 1u);
            else XB_SPIN(xb_ld(&bar[XB_TOPGEN]) == tg, bar);
            __builtin_amdgcn_fence(__ATOMIC_ACQUIRE, "agent");
            xb_add(&bar[XB_XGEN(b.x)], 1u);
            asm volatile("s_waitcnt vmcnt(0)" ::: "memory");
        } else {
            XB_SPIN(xb_ld(&bar[XB_XGEN(b.x)]) == gen, bar);
            __builtin_amdgcn_fence(__ATOMIC_ACQUIRE, "agent");
            asm volatile("s_waitcnt vmcnt(0)" ::: "memory");
        }
    }
    __syncthreads();
}
constexpr int NWAVES = 8;
constexpr int DM = 1024, TP = 8192, MP = 16384, MS = 256, MT = 16640, DEPTH = 4;
constexpr int NIN = 5888, NUP = 5632, DFF = 2816, INC = 5640, PASTL = 4096;
constexpr float EPSN = 1e-6f;
constexpr float L2E = 1.4426950408889634f;
constexpr float MEMC2 = 0.08838834764831845f * 1.4426950408889634f;

constexpr size_t O_Y = 0, O_YS = 16777216, O_KP = 17039360, O_VP = 50593792, O_LFP = 84148224, O_POOLP = 84672512, O_CONVP = 84733952,
                 O_MKP = 84824064, O_MVP = 85872640, O_KS = 86921216, O_VS = 87445504, O_LFS = 87969792, O_POOLS = 87977984, O_CONVS = 88469504, O_END = 89190400;

constexpr size_t MiB = 1u << 20;
constexpr size_t al1(size_t x) { return (x + (MiB - 1)) & ~(MiB - 1); }
constexpr size_t WS_CTL = 0, CTL_ZERO_BYTES = 1 * MiB;
constexpr size_t WE_IN = 0, WE_F = WE_IN + (size_t)NIN * 1024, WE_P = WE_F + 1024 * 512, WE_M = WE_P + 1024 * 512, WE_O = WE_M + 1024 * 512,
                 WE_UP = WE_O + 1024 * 1024, WE_DN = WE_UP + (size_t)NUP * 1024, WE_LAYER = WE_DN + (size_t)1024 * DFF;
constexpr size_t WS_W = 2 * MiB;
constexpr size_t WS_WMEM = al1(WS_W + DEPTH * WE_LAYER * 2);
constexpr size_t WS_H = al1(WS_WMEM + (size_t)4096 * 1024 * 2);
constexpr size_t WS_Q = al1(WS_H + (size_t)MT * 1024 * 2);
constexpr size_t WS_K = al1(WS_Q + (size_t)MT * 512 * 2);
constexpr size_t WS_V = al1(WS_K + (size_t)MT * 512 * 2);
constexpr size_t WS_PU = al1(WS_V + (size_t)MT * 512 * 2);
constexpr size_t WS_MQ = al1(WS_PU + (size_t)MT * 512 * 2);
constexpr size_t WS_G = al1(WS_MQ + (size_t)MT * 512 * 2);
constexpr size_t WS_LFT = al1(WS_G + (size_t)MT * 3072 * 2);
constexpr size_t WS_AO = al1(WS_LFT + (size_t)8 * MT * 4);
constexpr size_t WS_MIX = al1(WS_AO + (size_t)MT * 512 * 2);
constexpr size_t WS_MO = al1(WS_MIX + (size_t)MT * 512 * 2);
constexpr size_t WS_MF32 = al1(WS_MO + (size_t)MT * 512 * 2);
constexpr size_t WS_MRG = al1(WS_MF32 + (size_t)MT * 1024 * 4);
constexpr size_t WS_OUTF = al1(WS_MRG + (size_t)MT * 1024 * 2);
constexpr size_t WS_UP = al1(WS_OUTF + (size_t)MT * 1024 * 4);
constexpr size_t WS_HH = al1(WS_UP + (size_t)MT * NUP * 2);
constexpr size_t WS_MEMA = al1(WS_HH + (size_t)MT * DFF * 2);
constexpr size_t WS_MKP = al1(WS_MEMA + (size_t)512 * 1024 * 2);
constexpr size_t WS_MVTP = al1(WS_MKP + (size_t)4 * 512 * 512 * 2);
constexpr size_t WS_MKS = al1(WS_MVTP + (size_t)4 * 512 * 512 * 2);
constexpr size_t WS_MVTS = al1(WS_MKS + (size_t)4 * 4096 * 512 * 2);
constexpr size_t WS_SUF = al1(WS_MVTS + (size_t)4 * 4096 * 512 * 2);
constexpr size_t WS_END = al1(WS_SUF + (size_t)4 * 16 * 8 * 4096 * 4);
constexpr int CW_TMO = 0, CW_BAR = 4096;

constexpr int RING_OFF = 0, RING_BYTES = 131072;
constexpr int LDSCTL_OFF = RING_BYTES, MISC_OFF = LDSCTL_OFF + 320;
constexpr int LDS_BYTES = 147456;
static_assert(attn_body::LDS_BYTES <= RING_BYTES, "attention LDS");

struct Args { const float* in[29]; float* out; unsigned char* ws; int ph_lo, ph_hi, use_bar, pad; };

struct Frame {
    LAS unsigned char* lds;
    int tid, lane, wave, vcu, G;
    const float* const* in;
    float* out; unsigned char* ws;
};
#define WSP(T, off) ((T*)(F.ws + (off)))

__device__ __forceinline__ float wave_sum(float v) {
#pragma unroll
    for (int o = 1; o < 64; o <<= 1) v += __shfl_xor(v, o);
    return v;
}
__device__ __forceinline__ unsigned cvtpk(float lo, float hi) { return pg8::cvt_pk_bf16(lo, hi); }
__device__ __forceinline__ float bf2f(unsigned short b) { return __uint_as_float(((unsigned)b) << 16); }
__device__ __forceinline__ float bflo(unsigned w) { return __uint_as_float(w << 16); }
__device__ __forceinline__ float bfhi(unsigned w) { return __uint_as_float(w & 0xffff0000u); }

__device__ __forceinline__ int in_src_col(int n) { return n < 1536 ? n : (n < 5632 ? n + 8 : (n < 5640 ? n - 5632 + 1536 : -1)); }
__device__ __forceinline__ int up_src_col(int n) { const int pn = n >> 8, w = n & 255; return (w >> 7) * DFF + 128 * pn + (w & 127); }

__device__ __forceinline__ void tr64(const float* W, size_t ldw, int sc, const float* gain, int k0, bf16* WT, size_t ldt, int n0, LAS unsigned* scr, int lane) {
#pragma unroll
    for (int hf = 0; hf < 2; ++hf) {
        float a[32];
#pragma unroll
        for (int i = 0; i < 32; ++i) a[i] = (sc >= 0) ? W[(size_t)(k0 + 32 * hf + i) * ldw + sc] : 0.f;
        if (gain) {
#pragma unroll
            for (int i = 0; i < 32; ++i) a[i] *= gain[k0 + 32 * hf + i];
        }
#pragma unroll
        for (int i = 0; i < 16; ++i) scr[lane * 33 + 16 * hf + i] = cvtpk(a[2 * i], a[2 * i + 1]);
    }
    LDS_WAIT(); asm volatile("" ::: "memory");
    const int c = lane & 7;
#pragma unroll
    for (int j = 0; j < 8; ++j) { const int n = (lane >> 3) + 8 * j; const LAS unsigned* s = scr + n * 33 + 4 * c;
        v4u o; o.x = s[0]; o.y = s[1]; o.z = s[2]; o.w = s[3];
        *(GAS v4u*)(WT + (size_t)(n0 + n) * ldt + k0 + 8 * c) = o; }
    LDS_WAIT(); asm volatile("" ::: "memory");
}
__device__ __forceinline__ void fold_pool_item(const float* wpool, const float* ps, const float* wbr, bf16* WT, int k0, int n0, int lane) {
    const int g = k0 >> 7; const float* wp = wpool + (size_t)g * 16384 + (size_t)((k0 & 127) + lane) * 128;
    float acc[64];
#pragma unroll
    for (int i = 0; i < 64; ++i) acc[i] = 0.f;
    for (int j = 0; j < 128; ++j) {
        const float a = wp[j] * ps[128 * g + j]; const float* br = wbr + (size_t)(128 * g + j) * 1024 + n0;
#pragma unroll
        for (int i = 0; i < 64; ++i) acc[i] += a * br[i];
    }
#pragma unroll
    for (int i = 0; i < 64; ++i) WT[(size_t)(n0 + i) * 512 + k0 + lane] = (bf16)f2bf(acc[i]);
}
__device__ __forceinline__ void rms_row_to_bf16(const float* xrow, bf16* orow, int lane) {
    const GAS f32x4* xr = (const GAS f32x4*)xrow + lane;
    f32x4 v[4]; float s = 0.f;
#pragma unroll
    for (int j = 0; j < 4; ++j) { v[j] = xr[64 * j]; s += (v[j].x * v[j].x + v[j].y * v[j].y) + (v[j].z * v[j].z + v[j].w * v[j].w); }
    const float r = 1.0f / sqrtf(wave_sum(s) * (1.f / 1024.f) + EPSN);
    GAS unsigned long long* o8 = (GAS unsigned long long*)orow + lane;
#pragma unroll
    for (int j = 0; j < 4; ++j) o8[64 * j] = (unsigned long long)cvtpk(v[j].x * r, v[j].y * r) | ((unsigned long long)cvtpk(v[j].z * r, v[j].w * r) << 32);
}
__device__ __forceinline__ void suf_item(Frame& F, int lb) {
    const float* src = F.in[4] + (size_t)lb * PASTL * 8; float* dst = WSP(float, WS_SUF) + (size_t)lb * 8 * PASTL;
    LAS float* wsum = (LAS float*)(F.lds + RING_OFF);
    const int tid = F.tid, s_hi = PASTL - 1 - 8 * tid;
    float v[8][8];
    const f32x4* p = (const f32x4*)(src + (size_t)(s_hi - 7) * 8);
#pragma unroll
    for (int r = 0; r < 8; ++r) { const f32x4 a = p[2 * r], b = p[2 * r + 1]; const int k = 7 - r;
        v[k][0] = a.x; v[k][1] = a.y; v[k][2] = a.z; v[k][3] = a.w; v[k][4] = b.x; v[k][5] = b.y; v[k][6] = b.z; v[k][7] = b.w; }
    float tot[8], inc[8];
#pragma unroll
    for (int h = 0; h < 8; ++h) { float t = 0.f;
#pragma unroll
        for (int k = 0; k < 8; ++k) t += v[k][h];
        tot[h] = t; inc[h] = t; }
#pragma unroll
    for (int o = 1; o < 64; o <<= 1) {
#pragma unroll
        for (int h = 0; h < 8; ++h) { const float u = __shfl_up(inc[h], o); if (F.lane >= o) inc[h] += u; } }
    if (F.lane == 63) {
#pragma unroll
        for (int h = 0; h < 8; ++h) wsum[F.wave * 8 + h] = inc[h]; }
    __syncthreads();
#pragma unroll
    for (int h = 0; h < 8; ++h) { float pre = inc[h] - tot[h];
        for (int w = 0; w < NWAVES; ++w) { const float x = wsum[w * 8 + h]; if (w < F.wave) pre += x; }
        float x[8]; float run = pre;
#pragma unroll
        for (int k = 0; k < 8; ++k) { x[k] = run * L2E; run += v[k][h]; }
        f32x4* q = (f32x4*)(dst + (size_t)h * PASTL + (s_hi - 7));
        q[0] = (f32x4){x[7], x[6], x[5], x[4]}; q[1] = (f32x4){x[3], x[2], x[1], x[0]}; }
    __syncthreads();
}

__device__ __forceinline__ void p_prologue0(Frame& F) {
    for (int it = F.vcu; it < DEPTH * 16; it += F.G) suf_item(F, it);
    LAS unsigned* scr = (LAS unsigned*)(F.lds + RING_OFF + 1024 + F.wave * 8448);
    const int gw = F.vcu * NWAVES + F.wave, NGW = F.G * NWAVES;
    constexpr int I_IN = 16 * (NIN / 64), I_BR = 8 * 16, I_O = 16 * 16, I_UP = 16 * (NUP / 64), I_DN = (DFF / 64) * 16, I_MEM = 16 * 16, I_FOLD = 8 * 16;
    constexpr int I_LAYER = I_IN + 2 * I_BR + I_O + I_UP + I_DN + I_MEM + I_FOLD;
    constexpr int I_SMV = DEPTH * 16 * 4 * 4 * 2;
    constexpr int NITEMS = DEPTH * I_LAYER + I_SMV;
    for (int it0 = gw; it0 < NITEMS; it0 += NGW) {
        int it = it0;
        if (it >= DEPTH * I_LAYER) { it -= DEPTH * I_LAYER;
            const int lbh = it >> 3, r = it & 7, kb = r >> 1, nb = r & 1, lb = lbh >> 2, h = lbh & 3;
            tr64(F.in[8] + (size_t)lb * 256 * 512 + h * 128, 512, 64 * nb + F.lane, nullptr, 64 * kb, WSP(bf16, WS_MVTS) + (size_t)lbh * 128 * 256, 256, 64 * nb, scr, F.lane);
            continue; }
        const int l = it / I_LAYER; it -= l * I_LAYER;
        bf16* WL = WSP(bf16, WS_W) + (size_t)l * WE_LAYER;
        if (it < I_IN) { const int nblk = NIN / 64, kb = it / nblk, nb = it % nblk;
            tr64(F.in[10] + (size_t)l * 1024 * INC, INC, in_src_col(64 * nb + F.lane), F.in[21] + l * 1024, 64 * kb, WL + WE_IN, 1024, 64 * nb, scr, F.lane); continue; } it -= I_IN;
        if (it < I_BR) { const int kb = it / 16, nb = it % 16;
            tr64(F.in[17] + (size_t)l * 512 * 1024, 1024, 64 * nb + F.lane, nullptr, 64 * kb, WL + WE_F, 512, 64 * nb, scr, F.lane); continue; } it -= I_BR;
        if (it < I_BR) { const int kb = it / 16, nb = it % 16;
            tr64(F.in[19] + (size_t)l * 512 * 1024, 1024, 64 * nb + F.lane, nullptr, 64 * kb, WL + WE_M, 512, 64 * nb, scr, F.lane); continue; } it -= I_BR;
        if (it < I_O) { const int kb = it / 16, nb = it % 16;
            tr64(F.in[20] + (size_t)l * 1024 * 1024, 1024, 64 * nb + F.lane, nullptr, 64 * kb, WL + WE_O, 1024, 64 * nb, scr, F.lane); continue; } it -= I_O;
        if (it < I_UP) { const int nblk = NUP / 64, kb = it / nblk, nb = it % nblk;
            tr64(F.in[25] + (size_t)l * 1024 * NUP, NUP, up_src_col(64 * nb + F.lane), F.in[23] + l * 1024, 64 * kb, WL + WE_UP, 1024, 64 * nb, scr, F.lane); continue; } it -= I_UP;
        if (it < I_DN) { const int kb = it / 16, nb = it % 16;
            tr64(F.in[28] + (size_t)l * DFF * 1024, 1024, 64 * nb + F.lane, nullptr, 64 * kb, WL + WE_DN, DFF, 64 * nb, scr, F.lane); continue; } it -= I_DN;
        if (it < I_MEM) { const int kb = it / 16, nb = it % 16;
            tr64(F.in[15] + (size_t)l * 1024 * 1024, 1024, 64 * nb + F.lane, F.in[16] + l * 1024, 64 * kb, WSP(bf16, WS_WMEM) + (size_t)l * 1024 * 1024, 1024, 64 * nb, scr, F.lane); continue; } it -= I_MEM;
        { const int kb = it / 16, nb = it % 16;
          fold_pool_item(F.in[13] + (size_t)l * 4 * 16384, F.in[14] + l * 512, F.in[18] + (size_t)l * 512 * 1024, WL + WE_P, 64 * kb, 64 * nb, F.lane); }
    }
    for (int m = gw; m < MT + 512; m += NGW) {
        if (m < MP) rms_row_to_bf16(F.in[0] + (size_t)m * 1024, WSP(bf16, WS_H) + (size_t)m * 1024, F.lane);
        else if (m < MT) rms_row_to_bf16(F.in[1] + (size_t)(m - MP) * 1024, WSP(bf16, WS_H) + (size_t)m * 1024, F.lane);
        else rms_row_to_bf16(F.in[9] + (size_t)(m - MT) * 1024, WSP(bf16, WS_MEMA) + (size_t)(m - MT) * 1024, F.lane);
    }
    { const size_t n8 = (size_t)DEPTH * 4096 * 512 / 8; const f32x4* s = (const f32x4*)F.in[7]; v4u* d = WSP(v4u, WS_MKS);
      for (size_t i = (size_t)gw * 64 + F.lane; i < n8; i += (size_t)NGW * 64) { const f32x4 a = s[2 * i], b = s[2 * i + 1];
          v4u o; o.x = cvtpk(a.x, a.y); o.y = cvtpk(a.z, a.w); o.z = cvtpk(b.x, b.y); o.w = cvtpk(b.z, b.w); d[i] = o; } }
}

#define EPI_LOOP_BEGIN \
    _Pragma("unroll") for (int ai = 0; ai < 2; ++ai) _Pragma("unroll") for (int m = 0; m < 4; ++m) { const int row = u.pm * 256 + ai * 128 + wr * 64 + m * 16 + fr; \
    _Pragma("unroll") for (int bj = 0; bj < 2; ++bj) { const int c8 = u.pn * 256 + bj * 128 + wc * 32 + 8 * fq; f32x4 v0 = acc[ai][bj][m][0], v1 = acc[ai][bj][m][1];
#define EPI_LOOP_END } }
__device__ __forceinline__ v4u pack8(f32x4 v0, f32x4 v1) { v4u w; w.x = cvtpk(v0[0], v0[1]); w.y = cvtpk(v0[2], v0[3]); w.z = cvtpk(v1[0], v1[1]); w.w = cvtpk(v1[2], v1[3]); return w; }
__device__ __forceinline__ float sigmoidf_(float x) { return 1.0f / (1.0f + __expf(-x)); }
__device__ __forceinline__ float logsigmoidf_(float x) { return fminf(x, 0.f) - log1pf(__expf(-fabsf(x))); }

struct EpiIn {
    static constexpr bool PERM = true, AFTER_DRAIN = false;
    unsigned char* ws; float* out; const float* bgate; const float* bforget; int l;
    __device__ __forceinline__ void operator()(const f32x4 (&acc)[2][2][4][2], const pg8::Unit& u, int wr, int wc, int fr, int fq) const {
        const int pn = u.pn;
        if (pn < 2) { bf16* Q = (bf16*)(ws + WS_Q);
            EPI_LOOP_BEGIN v0 = v0 * attn_body::C2; v1 = v1 * attn_body::C2; *(v4u*)(Q + (size_t)row * 512 + c8) = pack8(v0, v1); EPI_LOOP_END
        } else if (pn < 6) { const bool isk = pn < 4; bf16* B = (bf16*)(ws + (isk ? WS_K : WS_V));
            EPI_LOOP_BEGIN const int c = c8 - (isk ? 512 : 1024); *(v4u*)(B + (size_t)row * 512 + c) = pack8(v0, v1);
                float* o = (row < MP) ? out + (isk ? O_KP : O_VP) + (size_t)l * 8388608 + (size_t)row * 512 + c : out + (isk ? O_KS : O_VS) + (size_t)l * 131072 + (size_t)(row - MP) * 512 + c;
                *(f32x4*)o = v0; *(f32x4*)(o + 4) = v1; EPI_LOOP_END
        } else if (pn < 8) { bf16* B = (bf16*)(ws + WS_PU);
            EPI_LOOP_BEGIN const int c = c8 - 1536; *(v4u*)(B + (size_t)row * 512 + c) = pack8(v0, v1);
                if (row < MP) { const int t = row & (TP - 1); if (t >= TP - 15) { float* o = out + O_POOLP + ((size_t)(l * 2 + (row >> 13)) * 15 + (t - (TP - 15))) * 512 + c; *(f32x4*)o = v0; *(f32x4*)(o + 4) = v1; } }
                else { const int rs = row - MP, ts = rs & 15; if (ts >= 1) { float* o = out + O_POOLS + ((size_t)(l * 16 + (rs >> 4)) * 15 + (ts - 1)) * 512 + c; *(f32x4*)o = v0; *(f32x4*)(o + 4) = v1; } }
            EPI_LOOP_END
        } else if (pn < 10) { bf16* B = (bf16*)(ws + WS_MQ);
            EPI_LOOP_BEGIN v0 = v0 * MEMC2; v1 = v1 * MEMC2; *(v4u*)(B + (size_t)row * 512 + (c8 - 2048)) = pack8(v0, v1); EPI_LOOP_END
        } else if (pn < 22) { bf16* B = (bf16*)(ws + WS_G);
            EPI_LOOP_BEGIN const int c = c8 - 2560; const f32x4 b0 = *(const f32x4*)(bgate + c), b1 = *(const f32x4*)(bgate + c + 4);
                f32x4 g0, g1;
#pragma unroll
                for (int e = 0; e < 4; ++e) { g0[e] = sigmoidf_(v0[e] + b0[e]); g1[e] = sigmoidf_(v1[e] + b1[e]); }
                *(v4u*)(B + (size_t)row * 3072 + c) = pack8(g0, g1); EPI_LOOP_END
        } else { float* LFT = (float*)(ws + WS_LFT);
            if (wc == 0 && fq == 0) {
#pragma unroll
                for (int ai = 0; ai < 2; ++ai)
#pragma unroll
                    for (int m = 0; m < 4; ++m) { const int row = u.pm * 256 + ai * 128 + wr * 64 + m * 16 + fr; const f32x4 v0 = acc[ai][0][m][0], v1 = acc[ai][0][m][1];
                        f32x4 f0, f1;
#pragma unroll
                        for (int e = 0; e < 4; ++e) { f0[e] = logsigmoidf_(v0[e] + bforget[e]); f1[e] = logsigmoidf_(v1[e] + bforget[4 + e]); }
#pragma unroll
                        for (int e = 0; e < 4; ++e) { LFT[(size_t)e * MT + row] = f0[e]; LFT[(size_t)(4 + e) * MT + row] = f1[e]; }
                        float* o = (row < MP) ? out + O_LFP + (size_t)l * 131072 + (size_t)row * 8 : out + O_LFS + (size_t)l * 2048 + (size_t)(row - MP) * 8;
                        *(f32x4*)o = f0; *(f32x4*)(o + 4) = f1; }
            }
        }
    }
};
struct EpiMemKV {
    static constexpr bool PERM = true, AFTER_DRAIN = false;
    unsigned char* ws; float* out;
    __device__ __forceinline__ void operator()(const f32x4 (&acc)[2][2][4][2], const pg8::Unit& u, int wr, int wc, int fr, int fq) const {
        const int l = u.pn >> 2; const bool isk = (u.pn & 3) < 2;
        bf16* MK = (bf16*)(ws + WS_MKP) + (size_t)l * 512 * 512; bf16* MVT = (bf16*)(ws + WS_MVTP) + (size_t)l * 512 * 512;
        EPI_LOOP_BEGIN const int c = (c8 & 1023) - (isk ? 0 : 512);
            float* o = out + (isk ? O_MKP : O_MVP) + (size_t)l * 262144 + (size_t)row * 512 + c; *(f32x4*)o = v0; *(f32x4*)(o + 4) = v1;
            if (isk) *(v4u*)(MK + (size_t)row * 512 + c) = pack8(v0, v1);
            else { const int b = row >> 8, key = row & 255, h = c >> 7, d = c & 127; bf16* p = MVT + ((size_t)(b * 4 + h) * 128 + d) * 256 + key;
#pragma unroll
                for (int e = 0; e < 4; ++e) { p[(size_t)e * 256] = (bf16)f2bf(v0[e]); p[(size_t)(4 + e) * 256] = (bf16)f2bf(v1[e]); } }
        EPI_LOOP_END
    }
};
template <int SEG> struct EpiBranch {
    static constexpr bool PERM = true, AFTER_DRAIN = false;
    unsigned char* ws;
    __device__ __forceinline__ void operator()(const f32x4 (&acc)[2][2][4][2], const pg8::Unit& u, int wr, int wc, int fr, int fq) const {
        const bf16* G = (const bf16*)(ws + WS_G); float* MF = (float*)(ws + WS_MF32); bf16* MG = (bf16*)(ws + WS_MRG);
        EPI_LOOP_BEGIN const v4u gw = *(const v4u*)(G + (size_t)row * 3072 + SEG * 1024 + c8);
            v0[0] *= bflo(gw.x); v0[1] *= bfhi(gw.x); v0[2] *= bflo(gw.y); v0[3] *= bfhi(gw.y); v1[0] *= bflo(gw.z); v1[1] *= bfhi(gw.z); v1[2] *= bflo(gw.w); v1[3] *= bfhi(gw.w);
            float* mp = MF + (size_t)row * 1024 + c8;
            if (SEG > 0) { v0 = v0 + *(const f32x4*)mp; v1 = v1 + *(const f32x4*)(mp + 4); }
            if (SEG < 2) { *(f32x4*)mp = v0; *(f32x4*)(mp + 4) = v1; }
            else *(v4u*)(MG + (size_t)row * 1024 + c8) = pack8(v0, v1);
        EPI_LOOP_END
    }
};
struct EpiF32 {
    static constexpr bool PERM = true, AFTER_DRAIN = false;
    float* O;
    __device__ __forceinline__ void operator()(const f32x4 (&acc)[2][2][4][2], const pg8::Unit& u, int wr, int wc, int fr, int fq) const {
        EPI_LOOP_BEGIN float* o = O + (size_t)row * 1024 + c8; *(f32x4*)o = v0; *(f32x4*)(o + 4) = v1; EPI_LOOP_END
    }
};
struct EpiUp {
    static constexpr bool PERM = true, AFTER_DRAIN = false;
    unsigned char* ws; float* out; int l;
    __device__ __forceinline__ void operator()(const f32x4 (&acc)[2][2][4][2], const pg8::Unit& u, int wr, int wc, int fr, int fq) const {
        bf16* U = (bf16*)(ws + WS_UP);
        EPI_LOOP_BEGIN *(v4u*)(U + (size_t)row * NUP + c8) = pack8(v0, v1);
            const int oc = bj * DFF + 128 * u.pn + wc * 32 + 8 * fq;
            if (row < MP) { const int t = row & (TP - 1); if (t >= TP - 2) { float* o = out + O_CONVP + ((size_t)(l * 2 + (row >> 13)) * 2 + (t - (TP - 2))) * NUP + oc; *(f32x4*)o = v0; *(f32x4*)(o + 4) = v1; } }
            else { const int rs = row - MP, ts = rs & 15; if (ts >= 14) { float* o = out + O_CONVS + ((size_t)(l * 16 + (rs >> 4)) * 2 + (ts - 14)) * NUP + oc; *(f32x4*)o = v0; *(f32x4*)(o + 4) = v1; } }
        EPI_LOOP_END
    }
};

__device__ __forceinline__ void p_postnorm(Frame& F, int l, const float* gpost, bool first_read_input, bool write_h) {
    const int gw = F.vcu * NWAVES + F.wave, NGW = F.G * NWAVES;
    const float* OF = WSP(float, WS_OUTF); bf16* H = WSP(bf16, WS_H);
    f32x4 gv[4];
#pragma unroll
    for (int j = 0; j < 4; ++j) gv[j] = ((const f32x4*)gpost)[F.lane + 64 * j];
    for (int m = gw; m < MT; m += NGW) {
        const float* xin = first_read_input ? (m < MP ? F.in[0] + (size_t)m * 1024 : F.in[1] + (size_t)(m - MP) * 1024) : F.out + (size_t)m * 1024;
        const GAS f32x4* xr = (const GAS f32x4*)xin + F.lane; const GAS f32x4* orow = (const GAS f32x4*)(OF + (size_t)m * 1024) + F.lane;
        f32x4 x[4], o[4]; float s = 0.f;
#pragma unroll
        for (int j = 0; j < 4; ++j) { x[j] = xr[64 * j]; o[j] = orow[64 * j]; s += (o[j].x * o[j].x + o[j].y * o[j].y) + (o[j].z * o[j].z + o[j].w * o[j].w); }
        const float r = 1.0f / sqrtf(wave_sum(s) * (1.f / 1024.f) + EPSN); float s2 = 0.f;
#pragma unroll
        for (int j = 0; j < 4; ++j) { x[j] = x[j] + o[j] * r * gv[j]; s2 += (x[j].x * x[j].x + x[j].y * x[j].y) + (x[j].z * x[j].z + x[j].w * x[j].w); }
        GAS f32x4* xo = (GAS f32x4*)(F.out + (size_t)m * 1024) + F.lane;
#pragma unroll
        for (int j = 0; j < 4; ++j) xo[64 * j] = x[j];
        if (write_h) { const float r2 = 1.0f / sqrtf(wave_sum(s2) * (1.f / 1024.f) + EPSN);
            GAS unsigned long long* o8 = (GAS unsigned long long*)(H + (size_t)m * 1024) + F.lane;
#pragma unroll
            for (int j = 0; j < 4; ++j) o8[64 * j] = (unsigned long long)cvtpk(x[j].x * r2, x[j].y * r2) | ((unsigned long long)cvtpk(x[j].z * r2, x[j].w * r2) << 32); }
    }
}
__device__ __forceinline__ float gelu_tanh(float x) { const float u = 0.7978845608028654f * (x + 0.044715f * x * x * x); const float e = __expf(2.f * u); const float t = 1.f - 2.f / (e + 1.f); return 0.5f * x * (1.f + t); }
__device__ __forceinline__ void p_conv(Frame& F, int l) {
    const int gw = F.vcu * NWAVES + F.wave, NGW = F.G * NWAVES;
    const bf16* U = WSP(bf16, WS_UP); bf16* HH = WSP(bf16, WS_HH);
    const float* cw = F.in[26] + (size_t)l * 3 * NUP; const float* cb = F.in[27] + (size_t)l * NUP; const float* sc = F.in[6] + (size_t)l * 16 * 2 * NUP;
    constexpr int NJB = DFF / 256, NITEMS = (MT / 16) * NJB;
    for (int it = gw; it < NITEMS; it += NGW) {
        const int rb = it / NJB, jb = it % NJB; const int j0 = 256 * jb + 4 * F.lane;
        const int pc = 256 * (j0 >> 7) + (j0 & 127);
        f32x4 wg[3], wv[3];
#pragma unroll
        for (int k = 0; k < 3; ++k) { wg[k] = *(const f32x4*)(cw + (size_t)k * NUP + j0); wv[k] = *(const f32x4*)(cw + (size_t)k * NUP + DFF + j0); }
        const f32x4 bg = *(const f32x4*)(cb + j0), bv = *(const f32x4*)(cb + DFF + j0);
        const int row0 = 16 * rb;
        f32x4 g2, g1, v2, v1;
        auto ld = [&](int row, f32x4& g, f32x4& v) { const uint2 a = *(const uint2*)(U + (size_t)row * NUP + pc), b = *(const uint2*)(U + (size_t)row * NUP + pc + 128);
            g = (f32x4){bflo(a.x), bfhi(a.x), bflo(a.y), bfhi(a.y)}; v = (f32x4){bflo(b.x), bfhi(b.x), bflo(b.y), bfhi(b.y)}; };
        const bool seq_start = (row0 < MP) ? ((row0 & (TP - 1)) == 0) : true;
        if (!seq_start) { ld(row0 - 2, g2, v2); ld(row0 - 1, g1, v1); }
        else if (row0 < MP) { g2 = g1 = v2 = v1 = (f32x4){0.f, 0.f, 0.f, 0.f}; }
        else { const float* h = sc + (size_t)((row0 - MP) >> 4) * 2 * NUP; g2 = *(const f32x4*)(h + j0); v2 = *(const f32x4*)(h + DFF + j0); g1 = *(const f32x4*)(h + NUP + j0); v1 = *(const f32x4*)(h + NUP + DFF + j0); }
#pragma unroll 4
        for (int r = 0; r < 16; ++r) { f32x4 g0, v0; ld(row0 + r, g0, v0);
            const f32x4 zg = g2 * wg[0] + g1 * wg[1] + g0 * wg[2] + bg, zv = v2 * wv[0] + v1 * wv[1] + v0 * wv[2] + bv;
            uint2 o; o.x = cvtpk(gelu_tanh(zg[0]) * zv[0], gelu_tanh(zg[1]) * zv[1]); o.y = cvtpk(gelu_tanh(zg[2]) * zv[2], gelu_tanh(zg[3]) * zv[3]);
            *(uint2*)(HH + (size_t)(row0 + r) * DFF + j0) = o;
            g2 = g1; v2 = v1; g1 = g0; v1 = v0; }
    }
}
__device__ __forceinline__ void p_poolmix(Frame& F, int l) {
    const int gw = F.vcu * NWAVES + F.wave, NGW = F.G * NWAVES;
    const bf16* PU = WSP(bf16, WS_PU); bf16* MIX = WSP(bf16, WS_MIX);
    const int c0 = 8 * F.lane, w = 2 << (F.lane >> 4);
    for (int it = gw; it < MT / 16; it += NGW) {
        const int row0 = 16 * it; const bool samp = row0 >= MP; const int tb0 = samp ? 0 : (row0 & (TP - 1));
        const float* hist = samp ? F.in[5] + ((size_t)(l * 16 + ((row0 - MP) >> 4)) * 15) * 512 + c0 : nullptr;
        auto ldu = [&](int t, float (&u)[8]) {
            if (t >= 0) { const v4u a = *(const v4u*)(PU + (size_t)(row0 - tb0 + t) * 512 + c0);
                u[0] = bflo(a.x); u[1] = bfhi(a.x); u[2] = bflo(a.y); u[3] = bfhi(a.y); u[4] = bflo(a.z); u[5] = bfhi(a.z); u[6] = bflo(a.w); u[7] = bfhi(a.w); }
            else if (samp) { const f32x4 a = *(const f32x4*)(hist + (size_t)(15 + t) * 512), b = *(const f32x4*)(hist + (size_t)(15 + t) * 512 + 4);
                u[0] = a.x; u[1] = a.y; u[2] = a.z; u[3] = a.w; u[4] = b.x; u[5] = b.y; u[6] = b.z; u[7] = b.w; }
            else {
#pragma unroll
                for (int e = 0; e < 8; ++e) u[e] = 0.f; } };
        float s[8];
#pragma unroll
        for (int e = 0; e < 8; ++e) s[e] = 0.f;
        for (int j = 1; j < w; ++j) { float u[8]; ldu(tb0 - j, u);
#pragma unroll
            for (int e = 0; e < 8; ++e) s[e] += u[e]; }
        for (int r = 0; r < 16; ++r) { const int t = tb0 + r; float u[8], uo[8]; ldu(t, u);
#pragma unroll
            for (int e = 0; e < 8; ++e) s[e] += u[e];
            const float inv = 1.0f / (samp ? (float)w : (float)((t + 1 < w) ? t + 1 : w));
            v4u o; o.x = cvtpk(s[0] * inv - u[0], s[1] * inv - u[1]); o.y = cvtpk(s[2] * inv - u[2], s[3] * inv - u[3]); o.z = cvtpk(s[4] * inv - u[4], s[5] * inv - u[5]); o.w = cvtpk(s[6] * inv - u[6], s[7] * inv - u[7]);
            *(v4u*)(MIX + (size_t)(row0 + r) * 512 + c0) = o;
            ldu(t - w + 1, uo);
#pragma unroll
            for (int e = 0; e < 8; ++e) s[e] -= uo[e]; }
    }
}

typedef float f32x16 __attribute__((ext_vector_type(16)));
__device__ __forceinline__ void memattn_item(const bf16* Qp  , int nvalid, const bf16* Kh  , const bf16* VT  , bf16* Op, int lane) {
    const int r32 = lane & 31, hi = lane >> 5; const int qrow = r32 < nvalid ? r32 : nvalid - 1;
    bf16x8 qf[8];
#pragma unroll
    for (int s = 0; s < 8; ++s) qf[s] = *(const bf16x8*)(Qp + (size_t)qrow * 512 + 16 * s + 8 * hi);
    f32x16 o[4];
#pragma unroll
    for (int d = 0; d < 4; ++d) o[d] = (f32x16){};
    float mrun = -1e30f, lrun = 0.f;
    for (int t = 0; t < 4; ++t) {
        f32x16 p[2];
#pragma unroll
        for (int blk = 0; blk < 2; ++blk) { p[blk] = (f32x16){}; const bf16* kp = Kh + (size_t)(64 * t + 32 * blk + r32) * 512 + 8 * hi;
#pragma unroll
            for (int s = 0; s < 8; ++s) { const bf16x8 a = *(const bf16x8*)(kp + 16 * s); p[blk] = __builtin_amdgcn_mfma_f32_32x32x16_bf16(a, qf[s], p[blk], 0, 0, 0); } }
        float mx = p[0][0];
#pragma unroll
        for (int r = 0; r < 16; ++r) { mx = fmaxf(mx, p[0][r]); mx = fmaxf(mx, p[1][r]); }
        mx = fmaxf(mx, __shfl_xor(mx, 32));
        const float mnew = fmaxf(mrun, mx), alpha = __builtin_amdgcn_exp2f(mrun - mnew); mrun = mnew;
        float ls = 0.f;
#pragma unroll
        for (int blk = 0; blk < 2; ++blk)
#pragma unroll
            for (int r = 0; r < 16; ++r) { p[blk][r] = __builtin_amdgcn_exp2f(p[blk][r] - mnew); ls += p[blk][r]; }
        lrun = lrun * alpha + ls;
#pragma unroll
        for (int d = 0; d < 4; ++d) o[d] = o[d] * alpha;
#pragma unroll
        for (int blk = 0; blk < 2; ++blk)
#pragma unroll
            for (int s2 = 0; s2 < 2; ++s2) {
                v4u pw; pw.x = cvtpk(p[blk][8 * s2 + 0], p[blk][8 * s2 + 1]); pw.y = cvtpk(p[blk][8 * s2 + 2], p[blk][8 * s2 + 3]); pw.z = cvtpk(p[blk][8 * s2 + 4], p[blk][8 * s2 + 5]); pw.w = cvtpk(p[blk][8 * s2 + 6], p[blk][8 * s2 + 7]);
                const bf16x8 pb = __builtin_bit_cast(bf16x8, pw);
                const int kbase = 64 * t + 32 * blk + 16 * s2 + 4 * hi;
#pragma unroll
                for (int d = 0; d < 4; ++d) { const bf16* vp = VT + (size_t)(32 * d + r32) * 256 + kbase;
                    const uint2 a0 = *(const uint2*)vp, a1 = *(const uint2*)(vp + 8); v4u aw; aw.x = a0.x; aw.y = a0.y; aw.z = a1.x; aw.w = a1.y;
                    o[d] = __builtin_amdgcn_mfma_f32_32x32x16_bf16(__builtin_bit_cast(bf16x8, aw), pb, o[d], 0, 0, 0); }
            }
    }
    lrun += __shfl_xor(lrun, 32);
    const float inv = 1.0f / lrun;
    if (r32 < nvalid) {
#pragma unroll
        for (int d = 0; d < 4; ++d)
#pragma unroll
            for (int a = 0; a < 4; ++a) { uint2 w; w.x = cvtpk(o[d][4 * a] * inv, o[d][4 * a + 1] * inv); w.y = cvtpk(o[d][4 * a + 2] * inv, o[d][4 * a + 3] * inv);
                *(uint2*)(Op + (size_t)r32 * 512 + 32 * d + 8 * a + 4 * hi) = w; }
    }
}

typedef float f32x4s __attribute__((ext_vector_type(4)));
__device__ __forceinline__ void fox_sample_item(Frame& F, int l, int b, int h) {
    const int lane = F.lane, wv = F.wave, c = lane & 15, g = lane >> 4;
    const bf16* Qb = WSP(bf16, WS_Q) + (size_t)(MP + 16 * b) * 512 + h * 64;
    const bf16* Kn = WSP(bf16, WS_K) + (size_t)(MP + 16 * b) * 512 + h * 64;
    const bf16* Vn = WSP(bf16, WS_V) + (size_t)(MP + 16 * b) * 512 + h * 64;
    const float* Kc = F.in[2] + ((size_t)(l * 16 + b) * PASTL) * 512 + h * 64;
    const float* Vc = F.in[3] + ((size_t)(l * 16 + b) * PASTL) * 512 + h * 64;
    const float* suf = WSP(float, WS_SUF) + ((size_t)(l * 16 + b) * 8 + h) * PASTL;
    bf16x8 qf[2];
#pragma unroll
    for (int ks = 0; ks < 2; ++ks) qf[ks] = *(const bf16x8*)(Qb + (size_t)c * 512 + 32 * ks + 8 * g);
    f32x4s acc[4];
#pragma unroll
    for (int d = 0; d < 4; ++d) acc[d] = (f32x4s){0.f, 0.f, 0.f, 0.f};
    float mrun = -1e30f, lrun = 0.f;
    struct Stage { f32x4s k[4][2]; float v[4][8]; f32x4s bA, bB; };
    const int koff = c * 512 + 8 * g, voff = 4 * g * 512 + c;
    auto load = [&](int s0, Stage& S) {
#pragma unroll
        for (int kb = 0; kb < 2; ++kb)
#pragma unroll
            for (int ks = 0; ks < 2; ++ks) { const float* pu = Kc + (size_t)(s0 + 16 * kb) * 512 + 32 * ks; S.k[kb * 2 + ks][0] = *(const f32x4s*)(pu + koff); S.k[kb * 2 + ks][1] = *(const f32x4s*)(pu + koff + 4); }
#pragma unroll
        for (int d = 0; d < 4; ++d)
#pragma unroll
            for (int j = 0; j < 8; ++j) { const float* pu = Vc + (size_t)(s0 + (j < 4 ? j : 16 + (j - 4))) * 512 + 16 * d; S.v[d][j] = pu[voff]; }
        S.bA = *(const f32x4s*)(suf + s0 + 4 * g); S.bB = *(const f32x4s*)(suf + s0 + 16 + 4 * g);
    };
    auto softmax_pv = [&](f32x4s sA, f32x4s sB, const bf16x8 (&vf)[4]) {
        float mx = fmaxf(fmaxf(fmaxf(sA[0], sA[1]), fmaxf(sA[2], sA[3])), fmaxf(fmaxf(sB[0], sB[1]), fmaxf(sB[2], sB[3])));
        mx = fmaxf(mx, __shfl_xor(mx, 16)); mx = fmaxf(mx, __shfl_xor(mx, 32));
        const float mnew = fmaxf(mrun, mx), alpha = __builtin_amdgcn_exp2f(mrun - mnew); mrun = mnew;
        float ls = 0.f;
#pragma unroll
        for (int r = 0; r < 4; ++r) { sA[r] = __builtin_amdgcn_exp2f(sA[r] - mnew); sB[r] = __builtin_amdgcn_exp2f(sB[r] - mnew); ls += sA[r] + sB[r]; }
        lrun = lrun * alpha + ls;
        v4u pw; pw.x = cvtpk(sA[0], sA[1]); pw.y = cvtpk(sA[2], sA[3]); pw.z = cvtpk(sB[0], sB[1]); pw.w = cvtpk(sB[2], sB[3]);
        const bf16x8 pb = __builtin_bit_cast(bf16x8, pw);
#pragma unroll
        for (int d = 0; d < 4; ++d) { acc[d] = acc[d] * alpha; acc[d] = __builtin_amdgcn_mfma_f32_16x16x32_bf16(vf[d], pb, acc[d], 0, 0, 0); }
    };
    auto compute = [&](const Stage& S) {
        f32x4s sA = S.bA, sB = S.bB;
#pragma unroll
        for (int ks = 0; ks < 2; ++ks) {
            { const f32x4s a = S.k[ks][0], b2 = S.k[ks][1]; v4u w; w.x = cvtpk(a[0], a[1]); w.y = cvtpk(a[2], a[3]); w.z = cvtpk(b2[0], b2[1]); w.w = cvtpk(b2[2], b2[3]);
              sA = __builtin_amdgcn_mfma_f32_16x16x32_bf16(__builtin_bit_cast(bf16x8, w), qf[ks], sA, 0, 0, 0); }
            { const f32x4s a = S.k[2 + ks][0], b2 = S.k[2 + ks][1]; v4u w; w.x = cvtpk(a[0], a[1]); w.y = cvtpk(a[2], a[3]); w.z = cvtpk(b2[0], b2[1]); w.w = cvtpk(b2[2], b2[3]);
              sB = __builtin_amdgcn_mfma_f32_16x16x32_bf16(__builtin_bit_cast(bf16x8, w), qf[ks], sB, 0, 0, 0); }
        }
        bf16x8 vf[4];
#pragma unroll
        for (int d = 0; d < 4; ++d) { v4u w; w.x = cvtpk(S.v[d][0], S.v[d][1]); w.y = cvtpk(S.v[d][2], S.v[d][3]); w.z = cvtpk(S.v[d][4], S.v[d][5]); w.w = cvtpk(S.v[d][6], S.v[d][7]); vf[d] = __builtin_bit_cast(bf16x8, w); }
        softmax_pv(sA, sB, vf);
    };
    const int sbeg = 512 * wv;
    Stage S0, S1;
    load(sbeg, S0);
    for (int i = 0; i < 16; i += 2) {
        load(sbeg + 32 * (i + 1), S1);
        compute(S0);
        if (i + 2 < 16) load(sbeg + 32 * (i + 2), S0);
        compute(S1);
    }
    if (wv == 7) {
        const float* lfn = WSP(float, WS_LFT) + (size_t)h * MT + MP + 16 * b;
        float cum = lfn[c];
#pragma unroll
        for (int o = 1; o < 16; o <<= 1) { const float u = __shfl_up(cum, o, 16); if (c >= o) cum += u; }
        f32x4s sA, sB;
#pragma unroll
        for (int r = 0; r < 4; ++r) { sA[r] = -L2E * __shfl(cum, 4 * g + r, 16); sB[r] = 0.f; }
#pragma unroll
        for (int ks = 0; ks < 2; ++ks) { const bf16x8 a = *(const bf16x8*)(Kn + (size_t)c * 512 + 32 * ks + 8 * g); sA = __builtin_amdgcn_mfma_f32_16x16x32_bf16(a, qf[ks], sA, 0, 0, 0); }
#pragma unroll
        for (int r = 0; r < 4; ++r) { if (4 * g + r > c) sA[r] = -INFINITY; sB[r] = -INFINITY; }
        bf16x8 vf[4];
#pragma unroll
        for (int d = 0; d < 4; ++d) { v4u w; const bf16* vp = Vn + 16 * d + c;
            w.x = (unsigned)vp[(size_t)(4 * g + 0) * 512] | ((unsigned)vp[(size_t)(4 * g + 1) * 512] << 16); w.y = (unsigned)vp[(size_t)(4 * g + 2) * 512] | ((unsigned)vp[(size_t)(4 * g + 3) * 512] << 16); w.z = 0u; w.w = 0u;
            vf[d] = __builtin_bit_cast(bf16x8, w); }
        softmax_pv(sA, sB, vf);
    }
    lrun += __shfl_xor(lrun, 16); lrun += __shfl_xor(lrun, 32);
    LAS float* part = (LAS float*)(F.lds + RING_OFF) + wv * 1088;
    if (g == 0) { part[c] = mrun; part[16 + c] = lrun; }
#pragma unroll
    for (int d = 0; d < 4; ++d)
#pragma unroll
        for (int r = 0; r < 4; ++r) part[64 + (16 * d + 4 * g + r) * 16 + c] = acc[d][r];
    __syncthreads();
    { const LAS float* P = (const LAS float*)(F.lds + RING_OFF); const int q = F.tid & 15, d0 = F.tid >> 4;
      float ms = -1e30f;
#pragma unroll
      for (int w = 0; w < 8; ++w) ms = fmaxf(ms, P[w * 1088 + q]);
      float L = 0.f, o0 = 0.f, o1 = 0.f;
#pragma unroll
      for (int w = 0; w < 8; ++w) { const float f = __builtin_amdgcn_exp2f(P[w * 1088 + q] - ms); L += f * P[w * 1088 + 16 + q]; o0 += f * P[w * 1088 + 64 + d0 * 16 + q]; o1 += f * P[w * 1088 + 64 + (d0 + 32) * 16 + q]; }
      bf16* AO = WSP(bf16, WS_AO) + (size_t)(MP + 16 * b + q) * 512 + h * 64;
      AO[d0] = (bf16)f2bf(o0 / L); AO[d0 + 32] = (bf16)f2bf(o1 / L); }
    __syncthreads();
}

__device__ __forceinline__ void p_attn(Frame& F, int l, char* ldsg, int Gl, int bxl) {
    { const attn_body::AttnTensors AT{(const attn_body::bf16*)WSP(bf16, WS_Q), (const attn_body::bf16*)WSP(bf16, WS_K), (const attn_body::bf16*)WSP(bf16, WS_V), (attn_body::bf16*)WSP(bf16, WS_AO), WSP(float, WS_LFT)};
      const attn_body::StaticOrder S(Gl, bxl);
#ifndef SKIP_FOXP
      attn_body::attn_phase<attn_body::StaticOrder>(ldsg + RING_OFF, AT, S);
#endif
    }
    __syncthreads();
#ifndef SKIP_FOXS
    for (int it = F.vcu; it < 128; it += F.G) fox_sample_item(F, l, it >> 3, it & 7);
#endif
#ifndef SKIP_MEMA
    { const int gw = F.vcu * NWAVES + F.wave, NGW = F.G * NWAVES;
      for (int it = gw; it < 2048 + 64; it += NGW) {
          if (it < 2048) { const int bh = it >> 8, rb = it & 255, b = bh >> 2, h = bh & 3; const size_t row0 = (size_t)b * TP + 32 * rb;
              memattn_item(WSP(bf16, WS_MQ) + row0 * 512 + h * 128, 32, WSP(bf16, WS_MKP) + ((size_t)l * 512 + b * 256) * 512 + h * 128, WSP(bf16, WS_MVTP) + ((size_t)(l * 2 + b) * 4 + h) * 128 * 256, WSP(bf16, WS_MO) + row0 * 512 + h * 128, F.lane); }
          else { const int bh = it - 2048, b = bh >> 2, h = bh & 3; const size_t row0 = (size_t)MP + 16 * b;
              memattn_item(WSP(bf16, WS_MQ) + row0 * 512 + h * 128, 16, WSP(bf16, WS_MKS) + ((size_t)(l * 16 + b) * 256) * 512 + h * 128, WSP(bf16, WS_MVTS) + ((size_t)(l * 16 + b) * 4 + h) * 128 * 256, WSP(bf16, WS_MO) + row0 * 512 + h * 128, F.lane); }
      } }
#endif
#ifndef SKIP_POOL
    p_poolmix(F, l);
#endif
}

constexpr int PH_PER_LAYER = 9, N_PHASES = 2 + DEPTH * PH_PER_LAYER;
__global__ void __launch_bounds__(NWAVES * 64, 2) enc_fwd(Args args) {
    extern __shared__ __attribute__((aligned(16))) unsigned char lds[];
    Frame F;
    F.lds = (LAS unsigned char*)lds;
    F.tid = threadIdx.x; F.lane = F.tid & 63; F.wave = __builtin_amdgcn_readfirstlane(F.tid >> 6);
    F.G = gridDim.x; { const int bx = blockIdx.x; F.vcu = (F.G % 8 == 0) ? (bx % 8) * (F.G / 8) + bx / 8 : bx; }
    F.in = args.in; F.out = args.out; F.ws = args.ws;
    volatile LAS unsigned* MISC = (volatile LAS unsigned*)(F.lds + MISC_OFF);
    for (int u = F.tid; u < (LDS_BYTES - LDSCTL_OFF) / 4; u += NWAVES * 64) ((LAS unsigned*)(F.lds + LDSCTL_OFF))[u] = 0u;
    __syncthreads();
    unsigned* ctl = (unsigned*)(args.ws + WS_CTL);
    XcdBarrier bar; bar.bar = ctl + CW_BAR; bar.x = 0; bar.st = nullptr;
    if (args.use_bar) bar = xcd_barrier_post(ctl + CW_BAR, MISC + 8);
    const int lo = args.ph_lo, hi = args.ph_hi;
#define IN(k) (lo <= (k) && (k) < hi)
#define RELAUNDER() do { int t_ = threadIdx.x; asm volatile("" : "+v"(t_)); F.tid = t_; F.lane = t_ & 63; F.wave = __builtin_amdgcn_readfirstlane(t_ >> 6); } while (0)
#define SEAM(k) do { if (IN(k) && IN((k) + 1)) xcd_barrier(bar); } while (0)

#ifndef SKIP_PRO
    if (IN(0)) { p_prologue0(F); } SEAM(0);
#endif
    if (IN(1)) {
        pg8::Gemm g{WSP(pg8::bf16_t, WS_MEMA), WSP(pg8::bf16_t, WS_WMEM), 512, 4096, 1024}; pg8::StaticOrder S; S.init(512, 4096, F.G, (int)blockIdx.x);
        EpiMemKV E{F.ws, F.out};
        pg8::gemm_phase<EpiMemKV, pg8::StaticOrder, true, true>(F.lds + RING_OFF, g, S, E);
    } SEAM(1);
    for (int l = 0; l < DEPTH; ++l) {
        const int pb = 2 + l * PH_PER_LAYER;
        int Gl = F.G, bxl = (int)blockIdx.x; asm volatile("" : "+s"(Gl), "+s"(bxl));
        const pg8::bf16_t* WL = WSP(pg8::bf16_t, WS_W) + (size_t)l * WE_LAYER;
        if (IN(pb + 0)) {
            pg8::Gemm g{WSP(pg8::bf16_t, WS_H), WL + WE_IN, MT, NIN, 1024}; pg8::StaticOrder S; S.init(MT, NIN, Gl, bxl);
            EpiIn E{F.ws, F.out, F.in[12] + (size_t)l * 3072, F.in[11] + l * 8, l};
            pg8::gemm_phase<EpiIn, pg8::StaticOrder, true, true>(F.lds + RING_OFF, g, S, E);
        } SEAM(pb + 0);
        if (IN(pb + 1)) { RELAUNDER(); p_attn(F, l, (char*)lds, Gl, bxl); } SEAM(pb + 1);
        if (IN(pb + 2)) {
            pg8::StaticOrder S; S.init(MT, 1024, Gl, bxl);
            { pg8::Gemm g{WSP(pg8::bf16_t, WS_AO), WL + WE_F, MT, 1024, 512}; EpiBranch<0> E{F.ws}; pg8::gemm_phase<EpiBranch<0>, pg8::StaticOrder, true, true>(F.lds + RING_OFF, g, S, E); }
            { pg8::Gemm g{WSP(pg8::bf16_t, WS_MIX), WL + WE_P, MT, 1024, 512}; EpiBranch<1> E{F.ws}; pg8::gemm_phase<EpiBranch<1>, pg8::StaticOrder, true, true>(F.lds + RING_OFF, g, S, E); }
            { pg8::Gemm g{WSP(pg8::bf16_t, WS_MO), WL + WE_M, MT, 1024, 512}; EpiBranch<2> E{F.ws}; pg8::gemm_phase<EpiBranch<2>, pg8::StaticOrder, true, true>(F.lds + RING_OFF, g, S, E); }
        } SEAM(pb + 2);
        if (IN(pb + 3)) {
            pg8::Gemm g{WSP(pg8::bf16_t, WS_MRG), WL + WE_O, MT, 1024, 1024}; pg8::StaticOrder S; S.init(MT, 1024, Gl, bxl);
            EpiF32 E{WSP(float, WS_OUTF)};
            pg8::gemm_phase<EpiF32, pg8::StaticOrder, true, true>(F.lds + RING_OFF, g, S, E);
        } SEAM(pb + 3);
        if (IN(pb + 4)) { RELAUNDER(); p_postnorm(F, l, F.in[22] + l * 1024, l == 0, true); } SEAM(pb + 4);
        if (IN(pb + 5)) {
            pg8::Gemm g{WSP(pg8::bf16_t, WS_H), WL + WE_UP, MT, NUP, 1024}; pg8::StaticOrder S; S.init(MT, NUP, Gl, bxl);
            EpiUp E{F.ws, F.out, l};
            pg8::gemm_phase<EpiUp, pg8::StaticOrder, true, true>(F.lds + RING_OFF, g, S, E);
        } SEAM(pb + 5);
#ifndef SKIP_CONV
        if (IN(pb + 6)) { RELAUNDER(); p_conv(F, l); } SEAM(pb + 6);
#endif
        if (IN(pb + 7)) {
            pg8::Gemm g{WSP(pg8::bf16_t, WS_HH), WL + WE_DN, MT, 1024, DFF}; pg8::StaticOrder S; S.init(MT, 1024, Gl, bxl);
            EpiF32 E{WSP(float, WS_OUTF)};
            pg8::gemm_phase<EpiF32, pg8::StaticOrder, true, true>(F.lds + RING_OFF, g, S, E);
        } SEAM(pb + 7);
        if (IN(pb + 8)) { RELAUNDER(); p_postnorm(F, l, F.in[24] + l * 1024, false, l + 1 < DEPTH); } SEAM(pb + 8);
    }
#undef IN
#undef SEAM
}

#ifndef N_LAUNCH_MODE
#define N_LAUNCH_MODE 0
#endif
extern "C" void kernel_launch(void* const* d_in, const int* in_sizes, int n_in, void* d_out, int out_size, void* d_ws, size_t ws_size, hipStream_t stream) {
    static int grid = 0;
    if (grid == 0) {
        if (n_in != 29 || (size_t)out_size != O_END || ws_size < WS_END) { fprintf(stderr, "kernel_launch: unexpected problem (n_in %d out %d ws %zu need %zu)\n", n_in, out_size, ws_size, (size_t)WS_END); grid = -1; return; }
        int dev = 0, cus = 0, per_cu = 0;
        if (hipGetDevice(&dev) != hipSuccess || hipDeviceGetAttribute(&cus, hipDeviceAttributeMultiprocessorCount, dev) != hipSuccess) { grid = -1; return; }
        if (hipFuncSetAttribute((const void*)enc_fwd, hipFuncAttributeMaxDynamicSharedMemorySize, LDS_BYTES) != hipSuccess) { fprintf(stderr, "kernel_launch: hipFuncSetAttribute failed\n"); grid = -1; return; }
        if (hipOccupancyMaxActiveBlocksPerMultiprocessor(&per_cu, (const void*)enc_fwd, NWAVES * 64, LDS_BYTES) != hipSuccess || per_cu < 1) fprintf(stderr, "kernel_launch: occupancy query says %d\n", per_cu);
        (void)hipGetLastError();
        grid = cus;
    }
    if (grid < 0) return;
    if (hipMemsetAsync((char*)d_ws + WS_CTL, 0, CTL_ZERO_BYTES, stream) != hipSuccess) return;
    Args a{};
    for (int i = 0; i < 29; ++i) a.in[i] = (const float*)d_in[i];
    a.out = (float*)d_out; a.ws = (unsigned char*)d_ws; a.pad = 0;
#if N_LAUNCH_MODE == 1
    a.ph_lo = 0; a.ph_hi = N_PHASES; a.use_bar = 1;
    hipLaunchKernelGGL(enc_fwd, dim3(grid), dim3(NWAVES * 64), LDS_BYTES, stream, a);
#else
    for (int p = 0; p < N_PHASES; ++p) { a.ph_lo = p; a.ph_hi = p + 1; a.use_bar = 0;
        hipLaunchKernelGGL(enc_fwd, dim3(grid), dim3(NWAVES * 64), LDS_BYTES, stream, a); }
#endif
}
```

```cpp
#define N_LAUNCH_MODE 1
#include <hip/hip_bf16.h>
#include <cmath>
#include <hip/hip_runtime.h>
#include <cstdio>
#include <cstdint>
namespace pg8 {
#define PG8_LAS __attribute__((address_space(3)))
typedef unsigned short bf16_t;
typedef short bf16x8 __attribute__((ext_vector_type(8)));
typedef float f32x4 __attribute__((ext_vector_type(4)));
typedef unsigned u32x4 __attribute__((ext_vector_type(4)));
constexpr int BM = 256, BK = 64, HALF = 128, HTB = HALF * BK * 2  , STAGE_BYTES = 8 * HTB, NXCD = 8, WGM = 8;

__host__ __device__ __forceinline__ int lds_byte(int r, int c) { const int st = (r >> 4) * 2 + (c >> 5), rr = r & 15, cc = c & 31, ob = rr * 64 + cc * 2; return st * 1024 + (ob ^ (((ob >> 9) & 1) << 5)); }
__host__ __device__ __forceinline__ void stage_rc(int b, int& R, int& C) { const int st = b / 1024, sb = b % 1024, swz = sb ^ (((sb >> 9) & 1) << 5); R = (st >> 1) * 16 + swz / 64; C = (st & 1) * 32 + (swz % 64) / 2; }
__host__ __device__ __forceinline__ int perm32(int rho) { const int n = rho >> 4, i = rho & 15; return 8 * (i >> 2) + 4 * n + (i & 3); }

struct Unit { int pm, pn; };
struct Gemm { const bf16_t* A; const bf16_t* Bt; int M, N, K; };

struct StaticOrder {
    int nM, nN, nwg, G, c;
    __host__ __device__ void init(int M, int N, int G_, int c_) { nM = M / BM; nN = N / BM; nwg = nM * nN; G = G_; c = c_; }
    __host__ __device__ bool next(int i, Unit& u) const {
        const long L = (long)i * G + c; if (L >= nwg) return false;
        int wgid = (int)L; { const int q = nwg / NXCD, r = nwg % NXCD, xcd = wgid % NXCD, off = wgid / NXCD; wgid = (xcd < r ? xcd * (q + 1) : r * (q + 1) + (xcd - r) * q) + off; }
        const int nig = WGM * nN, gid = wgid / nig, fm = gid * WGM, gsz = (nM - fm) < WGM ? (nM - fm) : WGM;
        u.pm = fm + ((wgid % nig) % gsz); u.pn = (wgid % nig) / gsz; return true;
    }
    __device__ __forceinline__ void a_ready(const Unit&) const {}
    __device__ __forceinline__ void done(const Unit&) const {}
};

__device__ __forceinline__ unsigned cvt_pk_bf16(float lo, float hi) { unsigned r; asm volatile("v_cvt_pk_bf16_f32 %0, %1, %2" : "=v"(r) : "v"(lo), "v"(hi)); return r; }
typedef float f32x2 __attribute__((ext_vector_type(2)));
__device__ __forceinline__ f32x2 gelu_pk(f32x2 v) {
    const f32x2 av = __builtin_elementwise_abs(v), d = av * 0.2316418882f + 1.0f;
    f32x2 t; t.x = __builtin_amdgcn_rcpf(d.x); t.y = __builtin_amdgcn_rcpf(d.y);
    f32x2 q = t * 0.5307027145f + (-0.7265760135f); q = q * t + 0.7107068705f; q = q * t + (-0.142248368f); q = q * t + 0.127414796f; q = q * t;
    const f32x2 s = (v * v) * (-0.72134752044f);
    f32x2 e; e.x = __builtin_amdgcn_exp2f(s.x); e.y = __builtin_amdgcn_exp2f(s.y);
    const f32x2 m = v * (q * e), r = v - m;
    f32x2 o; o.x = v.x < 0.f ? m.x : r.x; o.y = v.y < 0.f ? m.y : r.y; return o;
}

template <int ACT  > struct EpiBf16 {
    static constexpr bool PERM = true, AFTER_DRAIN = false; static_assert(ACT == 0 || ACT == 1, "EpiBf16: ACT is 0 (none) or 1 (gelu_pk)");
    bf16_t* O; int ldc; const float* bias; int split_cols; size_t split_stride; float scale0;
    __device__ __forceinline__ void operator()(const f32x4 (&acc)[2][2][4][2], const Unit& u, int wr, int wc, int fr, int fq) const {
        const int row0 = u.pm * BM + wr * 64 + fr; int colt = u.pn * BM; bf16_t* base = O;
        float sc = 1.f; if (split_cols) { const int t = colt / split_cols; base += (size_t)t * split_stride; colt -= t * split_cols; if (t == 0) sc = scale0; }
        const int col0 = colt + wc * 32 + 8 * fq, bcol0 = u.pn * BM + wc * 32 + 8 * fq;
        f32x4 bv[2][2];
#pragma unroll
        for (int bj = 0; bj < 2; ++bj)
#pragma unroll
            for (int n = 0; n < 2; ++n) bv[bj][n] = bias ? *(const f32x4*)(bias + bcol0 + bj * HALF + 4 * n) : (f32x4){0.f, 0.f, 0.f, 0.f};
#pragma unroll
        for (int ai = 0; ai < 2; ++ai)
#pragma unroll
            for (int m = 0; m < 4; ++m) { bf16_t* rowp = base + (size_t)(row0 + ai * HALF + m * 16) * ldc + col0;
#pragma unroll
                for (int bj = 0; bj < 2; ++bj) { f32x4 v0 = acc[ai][bj][m][0] + bv[bj][0], v1 = acc[ai][bj][m][1] + bv[bj][1];
                    if (ACT == 1) { f32x2 a = gelu_pk((f32x2){v0[0], v0[1]}), b = gelu_pk((f32x2){v0[2], v0[3]}), c = gelu_pk((f32x2){v1[0], v1[1]}), d = gelu_pk((f32x2){v1[2], v1[3]});
                        v0 = (f32x4){a.x, a.y, b.x, b.y}; v1 = (f32x4){c.x, c.y, d.x, d.y}; }
                    v0 = v0 * sc; v1 = v1 * sc; u32x4 w; w.x = cvt_pk_bf16(v0[0], v0[1]); w.y = cvt_pk_bf16(v0[2], v0[3]); w.z = cvt_pk_bf16(v1[0], v1[1]); w.w = cvt_pk_bf16(v1[2], v1[3]);
                    *(u32x4*)(rowp + bj * HALF) = w; } }
    }
};

struct PanelStats {
    unsigned* xbuf;
    unsigned* cnt;
    unsigned* tmo;
    int ntn; float eps;
    unsigned code;
    __device__ __forceinline__ bool run(const f32x4 (&v)[2][2][4][2], const Unit& u, int wr, int wc, int fr, int fq, PG8_LAS unsigned char* lds, int wid, int lane) const {
        typedef float f32x2v __attribute__((ext_vector_type(2)));
        PG8_LAS f32x2v* P = (PG8_LAS f32x2v*)lds;
        PG8_LAS f32x2v* S = (PG8_LAS f32x2v*)(lds + 8192);
        PG8_LAS unsigned* flag = (PG8_LAS unsigned*)(lds + 8192 + 2048);
#pragma unroll
        for (int ai = 0; ai < 2; ++ai)
#pragma unroll
            for (int m = 0; m < 4; ++m) {
                float s = 0.f;
#pragma unroll
                for (int bj = 0; bj < 2; ++bj)
#pragma unroll
                    for (int n = 0; n < 2; ++n) { const f32x4 x = v[ai][bj][m][n]; s += (x[0] + x[1]) + (x[2] + x[3]); }
                s += __shfl_xor(s, 16); s += __shfl_xor(s, 32);
                const float mw = s * (1.0f / 64.0f); float q = 0.f;
#pragma unroll
                for (int bj = 0; bj < 2; ++bj)
#pragma unroll
                    for (int n = 0; n < 2; ++n) { const f32x4 d = v[ai][bj][m][n] - mw; q += (d[0] * d[0] + d[1] * d[1]) + (d[2] * d[2] + d[3] * d[3]); }
                q += __shfl_xor(q, 16); q += __shfl_xor(q, 32);
                if (fq == 0) P[(ai * HALF + wr * 64 + m * 16 + fr) * 4 + wc] = (f32x2v){mw, q};
            }
        asm volatile("s_waitcnt lgkmcnt(0)" ::: "memory"); __builtin_amdgcn_s_barrier(); asm volatile("" ::: "memory");
#if defined(BROKEN_EXCHANGE_NO_WAIT)
#warning BROKEN CONTROL BUILD: the row-statistics exchange does not wait; results are wrong by design
        if (blockIdx.x >= 64) { const long long t0_ = clock64(); while (clock64() - t0_ < 60000) __builtin_amdgcn_s_sleep(8); }
#endif
        const int row = wid * 32 + (lane & 31);
        if (lane < 32) {
            const f32x2v a = P[row * 4 + 0], b = P[row * 4 + 1], c = P[row * 4 + 2], d = P[row * 4 + 3];
            const float mt = (a.x + b.x + c.x + d.x) * 0.25f;
            const float da = a.x - mt, db = b.x - mt, dc = c.x - mt, dd = d.x - mt;
            const float m2 = (a.y + b.y) + (c.y + d.y) + 64.0f * ((da * da + db * db) + (dc * dc + dd * dd));
            unsigned long long* slot = (unsigned long long*)xbuf + ((size_t)(u.pm * BM + row) * 4 + u.pn);
            __hip_atomic_store(slot, ((unsigned long long)__float_as_uint(m2) << 32) | __float_as_uint(mt), __ATOMIC_RELAXED, __HIP_MEMORY_SCOPE_AGENT);
        }
        asm volatile("s_waitcnt vmcnt(0)" ::: "memory");
        if (lane == 0) __hip_atomic_fetch_add(cnt + 64 * u.pm, 1u, __ATOMIC_RELAXED, __HIP_MEMORY_SCOPE_AGENT);
        if (wid == 0) {
            bool dead = false; const unsigned long long t0 = __builtin_amdgcn_s_memrealtime(); const unsigned want = 8u * (unsigned)ntn;
            for (;;) {
#if defined(BROKEN_EXCHANGE_NO_WAIT)
                break;
#endif
                if ((unsigned)__builtin_amdgcn_readfirstlane(__hip_atomic_load(cnt + 64 * u.pm, __ATOMIC_RELAXED, __HIP_MEMORY_SCOPE_AGENT)) >= want) break;
                if (__builtin_amdgcn_s_memrealtime() - t0 > 2000000ull) {
                    if (lane == 0) { unsigned expect = 0u; __hip_atomic_compare_exchange_strong(tmo + 1, &expect, code | (unsigned)(u.pm & 0xff), __ATOMIC_RELAXED, __ATOMIC_RELAXED, __HIP_MEMORY_SCOPE_AGENT);
                                     __hip_atomic_store(tmo, 1u, __ATOMIC_RELAXED, __HIP_MEMORY_SCOPE_AGENT); }
                    dead = true; break; }
                __builtin_amdgcn_s_sleep(2);
            }
            __builtin_amdgcn_fence(__ATOMIC_ACQUIRE, "agent");
            if (lane == 0) flag[0] = dead ? 1u : 0u;
        }
        asm volatile("s_waitcnt vmcnt(0) lgkmcnt(0)" ::: "memory"); __builtin_amdgcn_s_barrier(); asm volatile("" ::: "memory");
        const bool bad = flag[0] != 0u;
        if (lane < 32) {
            const unsigned long long* slot = (const unsigned long long*)xbuf + (size_t)(u.pm * BM + row) * 4; float mt[4], m2[4]; float ms = 0.f;
#pragma unroll
            for (int t = 0; t < 4; ++t) { if (t < ntn) { const unsigned long long w = __hip_atomic_load(slot + t, __ATOMIC_RELAXED, __HIP_MEMORY_SCOPE_AGENT); mt[t] = __uint_as_float((unsigned)w); m2[t] = __uint_as_float((unsigned)(w >> 32)); } else { mt[t] = 0.f; m2[t] = 0.f; } ms += mt[t]; }
            const float mean = ms / (float)ntn; float q = 0.f;
#pragma unroll
            for (int t = 0; t < 4; ++t) if (t < ntn) { const float dm = mt[t] - mean; q += m2[t] + 256.0f * dm * dm; }
            S[row] = (f32x2v){mean, 1.0f / sqrtf(q / (256.0f * (float)ntn) + eps)};
        }
        asm volatile("s_waitcnt lgkmcnt(0)" ::: "memory"); __builtin_amdgcn_s_barrier(); asm volatile("" ::: "memory");
        return bad;
    }
};
struct EpiLnRes {
    static constexpr bool PERM = false, AFTER_DRAIN = true;
    const float* base; float* out; int ldc; const float* bias; PanelStats st; unsigned poison;
    __device__ __forceinline__ void fused(f32x4 (&acc)[2][2][4][2], const Unit& u, int wr, int wc, int fr, int fq, PG8_LAS unsigned char* lds, int wid, int lane) const {
        typedef float f32x2v __attribute__((ext_vector_type(2)));
        const PG8_LAS f32x2v* S = (const PG8_LAS f32x2v*)(lds + 8192);
        const int col0 = u.pn * BM + wc * 32 + 4 * fq;
#pragma unroll
        for (int bj = 0; bj < 2; ++bj)
#pragma unroll
            for (int n = 0; n < 2; ++n) { const f32x4 bv = bias ? *(const f32x4*)(bias + col0 + bj * HALF + n * 16) : (f32x4){0.f, 0.f, 0.f, 0.f};
#pragma unroll
                for (int ai = 0; ai < 2; ++ai)
#pragma unroll
                    for (int m = 0; m < 4; ++m) acc[ai][bj][m][n] += bv; }
        f32x4 pre[4][2][2];
#pragma unroll
        for (int m = 0; m < 4; ++m) { const size_t off = (size_t)(u.pm * BM + wr * 64 + m * 16 + fr) * ldc + col0;
#pragma unroll
            for (int bj = 0; bj < 2; ++bj)
#pragma unroll
                for (int n = 0; n < 2; ++n) pre[m][bj][n] = *(const f32x4*)(base + off + bj * HALF + n * 16); }
        const bool bad = st.run(acc, u, wr, wc, fr, fq, lds, wid, lane) || poison != 0u;
        const float qnan = __builtin_nanf("");
#pragma unroll
        for (int ai = 0; ai < 2; ++ai)
#pragma unroll
            for (int m = 0; m < 4; ++m) { const int r = ai * HALF + wr * 64 + m * 16 + fr; const f32x2v sr = S[r]; const size_t off = (size_t)(u.pm * BM + r) * ldc + col0;
#pragma unroll
                for (int bj = 0; bj < 2; ++bj)
#pragma unroll
                    for (int n = 0; n < 2; ++n) { const f32x4 bs = ai == 0 ? pre[m][bj][n] : *(const f32x4*)(base + off + bj * HALF + n * 16); f32x4 o = bs + (acc[ai][bj][m][n] - sr.x) * sr.y;
                        if (bad) o = (f32x4){qnan, qnan, qnan, qnan}; *(f32x4*)(out + off + bj * HALF + n * 16) = o; }
                if (m & 1) asm volatile("" ::: "memory"); }
    }
};
struct EpiLnResLn {
    static constexpr bool PERM = false, AFTER_DRAIN = true;
    const float* base; float* out; bf16_t* xn; int ldc; const float* bias; PanelStats st1, st2; unsigned poison;
    __device__ __forceinline__ void fused(f32x4 (&acc)[2][2][4][2], const Unit& u, int wr, int wc, int fr, int fq, PG8_LAS unsigned char* lds, int wid, int lane) const {
        typedef float f32x2v __attribute__((ext_vector_type(2))); typedef unsigned u32x2v __attribute__((ext_vector_type(2)));
        const PG8_LAS f32x2v* S = (const PG8_LAS f32x2v*)(lds + 8192);
        const int col0 = u.pn * BM + wc * 32 + 4 * fq;
#pragma unroll
        for (int bj = 0; bj < 2; ++bj)
#pragma unroll
            for (int n = 0; n < 2; ++n) { const f32x4 bv = bias ? *(const f32x4*)(bias + col0 + bj * HALF + n * 16) : (f32x4){0.f, 0.f, 0.f, 0.f};
#pragma unroll
                for (int ai = 0; ai < 2; ++ai)
#pragma unroll
                    for (int m = 0; m < 4; ++m) acc[ai][bj][m][n] += bv; }
        bool bad = st1.run(acc, u, wr, wc, fr, fq, lds, wid, lane) || poison != 0u;
        const float qnan = __builtin_nanf("");
#pragma unroll
        for (int ai = 0; ai < 2; ++ai)
#pragma unroll
            for (int m = 0; m < 4; ++m) { const int r = ai * HALF + wr * 64 + m * 16 + fr; const f32x2v sr = S[r]; const size_t off = (size_t)(u.pm * BM + r) * ldc + col0;
#pragma unroll
                for (int bj = 0; bj < 2; ++bj)
#pragma unroll
                    for (int n = 0; n < 2; ++n) { const f32x4 bs = *(const f32x4*)(base + off + bj * HALF + n * 16); acc[ai][bj][m][n] = bs + (acc[ai][bj][m][n] - sr.x) * sr.y; }
                asm volatile("" : "+v"(acc[ai][0][m][0]), "+v"(acc[ai][0][m][1]), "+v"(acc[ai][1][m][0]), "+v"(acc[ai][1][m][1]));
                if (m & 1) asm volatile("" ::: "memory"); }
        const bool bad1 = bad;
        bad = st2.run(acc, u, wr, wc, fr, fq, lds, wid, lane) || bad;
#pragma unroll
        for (int ai = 0; ai < 2; ++ai)
#pragma unroll
            for (int m = 0; m < 4; ++m) { const int r = ai * HALF + wr * 64 + m * 16 + fr; const f32x2v sr = S[r]; const size_t off = (size_t)(u.pm * BM + r) * ldc + col0;
#pragma unroll
                for (int bj = 0; bj < 2; ++bj)
#pragma unroll
                    for (int n = 0; n < 2; ++n) { const f32x4 x1 = acc[ai][bj][m][n]; *(f32x4*)(out + off + bj * HALF + n * 16) = bad1 ? (f32x4){qnan, qnan, qnan, qnan} : x1;
                        const f32x4 o = (x1 - sr.x) * sr.y; u32x2v w; w.x = cvt_pk_bf16(o[0], o[1]); w.y = cvt_pk_bf16(o[2], o[3]);
                        if (bad) { w.x = 0x7fc07fc0u; w.y = 0x7fc07fc0u; } *(u32x2v*)(xn + off + bj * HALF + n * 16) = w; }
                asm volatile("" ::: "memory"); }
    }
};

template <class Epi, class Sched, bool ALIGN_EPI = false, bool SP2 = false>
__device__ __forceinline__ void gemm_phase(PG8_LAS unsigned char* lds, const Gemm g, const Sched& S, const Epi& E) {
    int tid_ = threadIdx.x; asm volatile("" : "+v"(tid_));
    const int tid = tid_, wid = __builtin_amdgcn_readfirstlane(tid >> 6), lane = tid & 63, wr = wid >> 2, wc = wid & 3, fr = lane & 15, fq = lane >> 4;
    const int K = g.K, nt = K / BK;
    unsigned voffA[2], voffB[2];
#pragma unroll
    for (int i = 0; i < 2; ++i) { int R, C; stage_rc(tid * 16 + i * 8192, R, C); const int Rb = Epi::PERM ? ((R & ~31) + perm32(R & 31)) : R;
        voffA[i] = (unsigned)(R * K + C) * 2u; voffB[i] = (unsigned)(Rb * K + C) * 2u; }
    const size_t kstep = (size_t)(BK * 2);
    const size_t hstep = (size_t)HALF * K * 2;
    const size_t tstep = 2 * hstep;
    const unsigned ldsw = (unsigned)wid * 1024u;
    const int aoff = lds_byte(wr * 64 + fr, fq * 8), boff = lds_byte(wc * 32 + fr, fq * 8);
#define PG8_SA(b, h) (((b) * 2 + (h)) * HTB)
#define PG8_SB(b, h) ((4 + (b) * 2 + (h)) * HTB)
#define PG8_STAGE(bufoff, gbase, voff) do { _Pragma("unroll") for (int _i = 0; _i < 2; ++_i) \
        __builtin_amdgcn_global_load_lds((const unsigned*)((const char*)(gbase) + (voff)[_i]), (PG8_LAS unsigned*)(lds + (bufoff) + ldsw + _i * 8192), 16, 0, 0); } while (0)
#define PG8_LDA(dst, b, h) do { _Pragma("unroll") for (int m = 0; m < 4; ++m) _Pragma("unroll") for (int k = 0; k < 2; ++k) dst[m][k] = *(const PG8_LAS bf16x8*)(lds + PG8_SA(b, h) + aoff + m * 2048 + k * 1024); } while (0)
#define PG8_LDB(dst, b, h) do { _Pragma("unroll") for (int n = 0; n < 2; ++n) _Pragma("unroll") for (int k = 0; k < 2; ++k) dst[n][k] = *(const PG8_LAS bf16x8*)(lds + PG8_SB(b, h) + boff + n * 2048 + k * 1024); } while (0)
#define PG8_MMA(ai, bj, At, Bt) do { __builtin_amdgcn_s_setprio(1); _Pragma("unroll") for (int m = 0; m < 4; ++m) _Pragma("unroll") for (int n = 0; n < 2; ++n) _Pragma("unroll") for (int k = 0; k < 2; ++k) \
        acc[ai][bj][m][n] = __builtin_amdgcn_mfma_f32_16x16x32_bf16(Bt[n][k], At[m][k], acc[ai][bj][m][n], 0, 0, 0); __builtin_amdgcn_s_setprio(0); } while (0)
#define PG8_WAIT_V(n) asm volatile("s_waitcnt vmcnt(" #n ")" ::: "memory")
#define PG8_WAIT_L(n) asm volatile("s_waitcnt lgkmcnt(" #n ")" ::: "memory")
#define PG8_BAR __builtin_amdgcn_s_barrier()
#define PG8_SCHED __builtin_amdgcn_sched_barrier(0)
    Unit cur, nxt; int ui = 0;
    if (!S.next(0, cur)) return;
    f32x4 acc[2][2][4][2];
#pragma unroll
    for (int a = 0; a < 2; ++a)
#pragma unroll
        for (int b = 0; b < 2; ++b)
#pragma unroll
            for (int m = 0; m < 4; ++m)
#pragma unroll
                for (int n = 0; n < 2; ++n) acc[a][b][m][n] = (f32x4){0.f, 0.f, 0.f, 0.f};
    bf16x8 At[4][2], B0[2][2], B1[2][2];
    const char* cA = (const char*)g.A + (size_t)cur.pm * tstep; const char* cB = (const char*)g.Bt + (size_t)cur.pn * tstep;
    S.a_ready(cur);
    if constexpr (SP2) {
        PG8_STAGE(PG8_SB(0, 0), cB, voffB); PG8_STAGE(PG8_SB(0, 1), cB + hstep, voffB); PG8_STAGE(PG8_SA(0, 0), cA, voffA); PG8_STAGE(PG8_SA(0, 1), cA + hstep, voffA);
        if (wr == 1) PG8_BAR;
        PG8_WAIT_V(2); PG8_BAR;
        PG8_STAGE(PG8_SB(1, 0), cB + kstep, voffB); PG8_STAGE(PG8_SA(1, 0), cA + kstep, voffA); PG8_STAGE(PG8_SB(1, 1), cB + hstep + kstep, voffB);
        PG8_WAIT_V(6); PG8_BAR;
    } else {
        PG8_STAGE(PG8_SB(0, 0), cB, voffB); PG8_STAGE(PG8_SA(0, 0), cA, voffA); PG8_STAGE(PG8_SB(0, 1), cB + hstep, voffB); PG8_STAGE(PG8_SA(0, 1), cA + hstep, voffA);
        if (wr == 1) PG8_BAR;
        PG8_WAIT_V(4); PG8_BAR;
        PG8_STAGE(PG8_SB(1, 0), cB + kstep, voffB); PG8_STAGE(PG8_SA(1, 0), cA + kstep, voffA); PG8_STAGE(PG8_SB(1, 1), cB + hstep + kstep, voffB);
        PG8_WAIT_V(6); PG8_BAR;
    }
    for (;;) {
        const bool has_next = S.next(ui + 1, nxt);
        const char* nA = has_next ? (const char*)g.A + (size_t)nxt.pm * tstep : cA; const char* nB = has_next ? (const char*)g.Bt + (size_t)nxt.pn * tstep : cB;
        for (int t = 0; t < nt; t += 2) {
            const bool last = (t == nt - 2);
            const char* a1 = cA + (size_t)(t + 1) * kstep;
            const char* a2 = last ? nA : cA + (size_t)(t + 2) * kstep; const char* b2 = last ? nB : cB + (size_t)(t + 2) * kstep;
            const char* a3 = a2 + kstep; const char* b3 = b2 + kstep;
            if (last && has_next) S.a_ready(nxt);
            if constexpr (SP2) {
            PG8_LDB(B0, 0, 0); PG8_LDB(B1, 0, 1); PG8_SCHED; PG8_LDA(At, 0, 0); PG8_STAGE(PG8_SA(1, 1), a1 + hstep, voffA);
            PG8_WAIT_V(8); PG8_WAIT_L(0); PG8_BAR; PG8_MMA(0, 0, At, B0); PG8_MMA(0, 1, At, B1); PG8_BAR; PG8_SCHED;
            PG8_LDA(At, 0, 1); PG8_STAGE(PG8_SB(0, 0), b2, voffB); PG8_STAGE(PG8_SB(0, 1), b2 + hstep, voffB); PG8_STAGE(PG8_SA(0, 0), a2, voffA);
            PG8_WAIT_V(8); PG8_WAIT_L(0); PG8_BAR; PG8_MMA(1, 0, At, B0); PG8_MMA(1, 1, At, B1); PG8_BAR; PG8_SCHED;
            PG8_LDB(B0, 1, 0); PG8_LDB(B1, 1, 1); PG8_SCHED; PG8_LDA(At, 1, 0); PG8_STAGE(PG8_SA(0, 1), a2 + hstep, voffA);
            PG8_WAIT_V(8); PG8_WAIT_L(0); PG8_BAR; PG8_MMA(0, 0, At, B0); PG8_MMA(0, 1, At, B1); PG8_BAR; PG8_SCHED;
            PG8_LDA(At, 1, 1); PG8_STAGE(PG8_SB(1, 0), b3, voffB); PG8_STAGE(PG8_SB(1, 1), b3 + hstep, voffB); PG8_STAGE(PG8_SA(1, 0), a3, voffA);
            PG8_WAIT_V(8); PG8_WAIT_L(0); PG8_BAR; PG8_MMA(1, 0, At, B0); PG8_MMA(1, 1, At, B1); PG8_BAR; PG8_SCHED;
            } else {
            PG8_LDB(B0, 0, 0); PG8_SCHED; PG8_LDA(At, 0, 0); PG8_STAGE(PG8_SA(1, 1), a1 + hstep, voffA);
            PG8_WAIT_L(8); PG8_BAR; PG8_WAIT_L(0); PG8_MMA(0, 0, At, B0); PG8_BAR; PG8_SCHED;
            PG8_LDB(B1, 0, 1); PG8_STAGE(PG8_SB(0, 0), b2, voffB);
            PG8_BAR; PG8_WAIT_L(0); PG8_MMA(0, 1, At, B1); PG8_BAR;
            PG8_LDA(At, 0, 1); PG8_STAGE(PG8_SA(0, 0), a2, voffA);
            PG8_BAR; PG8_WAIT_L(0); PG8_MMA(1, 0, At, B0); PG8_BAR; PG8_SCHED;
            PG8_STAGE(PG8_SB(0, 1), b2 + hstep, voffB);
            PG8_WAIT_V(6); PG8_BAR; PG8_MMA(1, 1, At, B1); PG8_BAR;
            PG8_LDB(B0, 1, 0); PG8_SCHED; PG8_LDA(At, 1, 0); PG8_STAGE(PG8_SA(0, 1), a2 + hstep, voffA);
            PG8_WAIT_L(8); PG8_BAR; PG8_WAIT_L(0); PG8_MMA(0, 0, At, B0); PG8_BAR; PG8_SCHED;
            PG8_LDB(B1, 1, 1); PG8_STAGE(PG8_SB(1, 0), b3, voffB);
            PG8_BAR; PG8_WAIT_L(0); PG8_MMA(0, 1, At, B1); PG8_BAR;
            PG8_LDA(At, 1, 1); PG8_STAGE(PG8_SA(1, 0), a3, voffA);
            PG8_BAR; PG8_WAIT_L(0); PG8_MMA(1, 0, At, B0); PG8_BAR; PG8_SCHED;
            PG8_STAGE(PG8_SB(1, 1), b3 + hstep, voffB);
            PG8_WAIT_V(6); PG8_BAR; PG8_MMA(1, 1, At, B1); PG8_BAR;
            }
        }
        if constexpr (ALIGN_EPI) { if (wr == 0) PG8_BAR; }
        if constexpr (!Epi::AFTER_DRAIN) { E(acc, cur, wr, wc, fr, fq); S.done(cur); }
        if (!has_next) break;
#pragma unroll
        for (int a = 0; a < 2; ++a)
#pragma unroll
            for (int b = 0; b < 2; ++b)
#pragma unroll
                for (int m = 0; m < 4; ++m)
#pragma unroll
                    for (int n = 0; n < 2; ++n) acc[a][b][m][n] = (f32x4){0.f, 0.f, 0.f, 0.f};
        cur = nxt; cA = nA; cB = nB; ++ui;
        if constexpr (ALIGN_EPI) { if (wr == 1) PG8_BAR; }
    }
    PG8_WAIT_V(0);
    if constexpr (!ALIGN_EPI) { if (wr == 0) PG8_BAR; }
    PG8_BAR;
    if constexpr (Epi::AFTER_DRAIN) { E.fused(acc, cur, wr, wc, fr, fq, lds, wid, lane); S.done(cur); }
#undef PG8_SA
#undef PG8_SB
#undef PG8_STAGE
#undef PG8_LDA
#undef PG8_LDB
#undef PG8_MMA
#undef PG8_WAIT_V
#undef PG8_WAIT_L
#undef PG8_BAR
#undef PG8_SCHED
}
}
namespace attn_body {
using bf16=__hip_bfloat16;
using bf16x8=__attribute__((ext_vector_type(8)))short;
using s16x4=__attribute__((ext_vector_type(4)))short;
using f32x16=__attribute__((ext_vector_type(16)))float;
using u32x4=__attribute__((ext_vector_type(4)))unsigned;
constexpr int BATCH=2,NHEAD=8,SEQ=8192,D=64,DM=NHEAD*D;
constexpr int NW=8,QBLK=32,QB=QBLK*NW,KVBLK=64,NQB=SEQ/QB;
constexpr int ATTN_PITCH=DM, ATTN_UNIT_ROWS=QB, LFT_PITCH=16640;
__device__ __forceinline__ int crow(int r,int hi){return (r&3)+8*(r>>2)+4*hi;}
#define SBAR() __builtin_amdgcn_sched_barrier(0)
__device__ __forceinline__ void cmask(f32x16&p0,f32x16&p1,int jb,int qrel,int hi){
  const float NEG=-INFINITY; int kb=64*jb+4*hi;
  #pragma unroll
  for(int r=0;r<16;++r){int kv=kb+(r&3)+8*(r>>2); if(kv>qrel)p0[r]=NEG; if(kv+32>qrel)p1[r]=NEG;}
}

constexpr int NSLOT=3, SLOTB=8192;
constexpr int LDS_K=0, LDS_V=NSLOT*SLOTB, LDS_WS=2*NSLOT*SLOTB, LDS_OST=LDS_WS+NW*64*4, LDS_KB=LDS_OST+NW*4096, LDS_BYTES=LDS_KB+SEQ*4;
constexpr float C2=0.125f*1.4426950408889634f;
__device__ __forceinline__ void glds16(const void*gsrc,unsigned lds_dst){unsigned keep;
  asm volatile("s_mov_b32 %0, m0\n\ts_mov_b32 m0, %2\n\ts_nop 0\n\tglobal_load_lds_dwordx4 %1, off\n\ts_mov_b32 m0, %0":"=&s"(keep):"v"(gsrc),"s"(lds_dst):"memory");}
__device__ __forceinline__ float max3f(float a,float b,float c){float r;asm("v_max3_f32 %0, %1, %2, %3":"=v"(r):"v"(a),"v"(b),"v"(c));return r;}
__device__ __forceinline__ float max2f(float a,float b){float r;asm("v_max_f32_e32 %0, %1, %2":"=v"(r):"v"(a),"v"(b));return r;}
__device__ __forceinline__ float fadd_s(float a,float b){float r;asm("v_add_f32_e32 %0, %1, %2":"=v"(r):"v"(a),"v"(b));return r;}
__device__ __forceinline__ float fsub_s(float a,float b){float r;asm("v_sub_f32_e32 %0, %1, %2":"=v"(r):"v"(a),"v"(b));return r;}
typedef float f32x2_t __attribute__((ext_vector_type(2))); typedef __bf16 bf16x2_t __attribute__((ext_vector_type(2)));
__device__ __forceinline__ unsigned cvtpk_s(float lo,float hi){f32x2_t v={lo,hi};bf16x2_t b=__builtin_convertvector(v,bf16x2_t);return __builtin_bit_cast(unsigned,b);}
#define WAIT_BAR(N) asm volatile("s_waitcnt vmcnt(" #N ") lgkmcnt(0)\n\ts_barrier":::"memory")

__device__ __forceinline__ void qkt(f32x16&p0,f32x16&p1,const char*Kslot,const bf16x8*qr,const f32x16&negm,int r32,int hi){
  const char*kb=Kslot+hi*1024+r32*16;
  #pragma unroll
  for(int d0=0;d0<4;++d0){
    const bf16x8 b0=*reinterpret_cast<const bf16x8*>(kb+d0*2048);
    const bf16x8 b1=*reinterpret_cast<const bf16x8*>(kb+d0*2048+512);
    p0=__builtin_amdgcn_mfma_f32_32x32x16_bf16(b0,qr[d0],p0,0,0,0);p1=__builtin_amdgcn_mfma_f32_32x32x16_bf16(b1,qr[d0],p1,0,0,0);}
}
typedef __attribute__((address_space(3))) const char* lds_cptr;
typedef short v4i16_t __attribute__((ext_vector_type(4)));
__device__ __forceinline__ void kload8(bf16x8*kf,lds_cptr kp){
  kf[0]=*(const __attribute__((address_space(3))) bf16x8*)(kp);      kf[1]=*(const __attribute__((address_space(3))) bf16x8*)(kp+512);
  kf[2]=*(const __attribute__((address_space(3))) bf16x8*)(kp+2048); kf[3]=*(const __attribute__((address_space(3))) bf16x8*)(kp+2560);
  kf[4]=*(const __attribute__((address_space(3))) bf16x8*)(kp+4096); kf[5]=*(const __attribute__((address_space(3))) bf16x8*)(kp+4608);
  kf[6]=*(const __attribute__((address_space(3))) bf16x8*)(kp+6144); kf[7]=*(const __attribute__((address_space(3))) bf16x8*)(kp+6656);
}
__device__ __forceinline__ void kload2(bf16x8*kf,lds_cptr kp,int j){ kf[2*j]=*(const __attribute__((address_space(3))) bf16x8*)(kp+j*2048); kf[2*j+1]=*(const __attribute__((address_space(3))) bf16x8*)(kp+j*2048+512); }
__device__ __forceinline__ s16x4 vtr(lds_cptr p){ return __builtin_bit_cast(s16x4,__builtin_amdgcn_ds_read_tr16_b64_v4i16((__attribute__((address_space(3))) v4i16_t*)p)); }
__device__ __forceinline__ float rowmax(const f32x16&p0,const f32x16&p1){
  float a=max3f(p0[0],p0[1],p1[0]),b=max3f(p0[2],p0[3],p1[1]);a=max3f(a,p1[2],p1[3]);
  #pragma unroll
  for(int r=4;r<16;r+=4){a=max3f(a,p0[r],p0[r+1]);b=max3f(b,p0[r+2],p0[r+3]);a=max3f(a,p1[r],p1[r+1]);b=max3f(b,p1[r+2],p1[r+3]);}
  const float m=max2f(a,b);
  auto rr=__builtin_amdgcn_permlane32_swap(__float_as_uint(m),__float_as_uint(m),false,false);
  return max2f(__uint_as_float(rr[0]),__uint_as_float(rr[1]));
}
__device__ __forceinline__ void pv(f32x16*o,int vb,bf16x8 pa0,bf16x8 pa1,bf16x8 pa2,bf16x8 pa3){
  #pragma unroll
  for(int d0=0;d0<2;++d0){s16x4 lo[4],hi[4];
    #pragma unroll
    for(int ks=0;ks<4;++ks){
      asm volatile("ds_read_b64_tr_b16 %0,%1 offset:%c2":"=&v"(lo[ks]):"v"(vb),"i"(d0*4096+ks*1024):"memory");
      asm volatile("ds_read_b64_tr_b16 %0,%1 offset:%c2":"=&v"(hi[ks]):"v"(vb),"i"(d0*4096+ks*1024+512):"memory");}
    asm volatile("s_waitcnt lgkmcnt(0)":::"memory");SBAR();
    #define PK(k) (bf16x8){lo[k][0],lo[k][1],lo[k][2],lo[k][3],hi[k][0],hi[k][1],hi[k][2],hi[k][3]}
    o[d0]=__builtin_amdgcn_mfma_f32_32x32x16_bf16(pa0,PK(0),o[d0],0,0,0);
    o[d0]=__builtin_amdgcn_mfma_f32_32x32x16_bf16(pa1,PK(1),o[d0],0,0,0);
    o[d0]=__builtin_amdgcn_mfma_f32_32x32x16_bf16(pa2,PK(2),o[d0],0,0,0);
    o[d0]=__builtin_amdgcn_mfma_f32_32x32x16_bf16(pa3,PK(3),o[d0],0,0,0);
    #undef PK
  }
}

#ifndef ATTN_STORE16
#define ATTN_STORE16(p,v) (*(u32x4*)(p)=(v))
#endif
template<int THRL> __device__ __forceinline__ void attn_unit(int b,int h,int qb,const bf16*Q,const bf16*__restrict__ K,const bf16*__restrict__ V,bf16*O,const float*LFT,char*shm){
  int tid_l=threadIdx.x; asm volatile("":"+v"(tid_l)); const int tid=tid_l,lane=tid&63,r32=lane&31,hi=lane>>5; const int wid=__builtin_amdgcn_readfirstlane(tid>>6);
  const long rowbase=(long)b*SEQ; const int q0=qb*QB;
  const bf16*Qw=Q+(rowbase+q0+wid*QBLK)*DM+h*D;
  const bf16*Kh=K+rowbase*DM+h*D,*Vh=V+rowbase*DM+h*D;
  const lds_cptr shm3=(lds_cptr)shm;
  const unsigned lds0=(unsigned)(uintptr_t)shm;
  float*wsf=(float*)(shm+LDS_WS)+wid*64;
  const bf16*ksrc=Kh+(long)lane*DM+wid*8;
  const bf16*vsrc=Vh+(long)(16*(wid&3)+(lane>>2))*DM+(wid>>2)*32+(lane&3)*8;
  const unsigned kdst=lds0+LDS_K+wid*1024, vdst=lds0+LDS_V+wid*1024;
  #define DMA_K(t,slot) glds16(ksrc+(long)(t)*KVBLK*DM,(unsigned)__builtin_amdgcn_readfirstlane(kdst+(slot)))
  #define DMA_V(t,slot) glds16(vsrc+(long)(t)*KVBLK*DM,(unsigned)__builtin_amdgcn_readfirstlane(vdst+(slot)))
  const int vb0=(int)(lds0+LDS_V)+((lane>>4)&1)*32+(lane&3)*8+(4*hi+((lane&15)>>2))*64;
  const char*Kbase=shm+LDS_K; bf16x8 kf[8];
  const lds_cptr kp0=shm3+LDS_K+hi*1024+r32*16; const lds_cptr vp0=shm3+LDS_V+((lane>>4)&1)*32+(lane&3)*8+(4*hi+((lane&15)>>2))*64;
  const int NT=(q0+QB)/KVBLK;
  { typedef float f32x4_t __attribute__((ext_vector_type(4)));
    const int n=q0+QB; const float*lf=LFT+(long)h*LFT_PITCH+rowbase; const int base=16*tid;
    __attribute__((address_space(3))) float*kbw=(__attribute__((address_space(3))) float*)(shm3+LDS_KB);
    __attribute__((address_space(3))) float*wsum=(__attribute__((address_space(3))) float*)(shm3+LDS_WS);
    float v[16]; float tot=0.f;
    if(base<n){ const f32x4_t*p=(const f32x4_t*)(lf+n-16-base);
      const f32x4_t a0=p[0],a1=p[1],a2=p[2],a3=p[3];
      v[0]=a3[3];v[1]=a3[2];v[2]=a3[1];v[3]=a3[0];v[4]=a2[3];v[5]=a2[2];v[6]=a2[1];v[7]=a2[0];v[8]=a1[3];v[9]=a1[2];v[10]=a1[1];v[11]=a1[0];v[12]=a0[3];v[13]=a0[2];v[14]=a0[1];v[15]=a0[0];
      #pragma unroll
      for(int k=0;k<16;++k)tot+=v[k]; }
    else{
      #pragma unroll
      for(int k=0;k<16;++k)v[k]=0.f; }
    float inc=tot;
    #pragma unroll
    for(int o=1;o<64;o<<=1){ const float u=__shfl_up(inc,o); if(lane>=o)inc+=u; }
    if(lane==63)wsum[wid]=inc;
    __syncthreads();
    float pre=inc-tot;
    #pragma unroll
    for(int w=0;w<NW;++w){ const float ws_=wsum[w]; if(w<wid)pre+=ws_; }
    if(base<n){ const float L2E=1.4426950408889634f; float x[16]; float run=pre;
      #pragma unroll
      for(int k=0;k<16;++k){ x[k]=run*L2E; run+=v[k]; }
      __attribute__((address_space(3))) f32x4_t*q4=(__attribute__((address_space(3))) f32x4_t*)(kbw+n-16-base);
      q4[0]=(f32x4_t){x[15],x[14],x[13],x[12]}; q4[1]=(f32x4_t){x[11],x[10],x[9],x[8]}; q4[2]=(f32x4_t){x[7],x[6],x[5],x[4]}; q4[3]=(f32x4_t){x[3],x[2],x[1],x[0]}; }
    __syncthreads();
  }
  DMA_K(0,0);DMA_V(0,0);DMA_K(1,SLOTB);
  bf16x8 qr[4];
  #pragma unroll
  for(int d0=0;d0<4;++d0)qr[d0]=*reinterpret_cast<const bf16x8*>(&Qw[(long)r32*DM+d0*16+hi*8]);
  float mhat=0.f,l_reg=0.f;f32x16 o[2];o[0]=f32x16{};o[1]=f32x16{};f32x16 negm=f32x16{};asm volatile("":"+v"(negm));
  const int qrel=wid*QBLK+r32;
  #define CMASK(P0,P1,t) do{int jb_=(t)-(NT-4); if(jb_>=0)cmask(P0,P1,jb_,qrel,hi);}while(0)
  bool resc=false;
  #define START(P0,P1) do{ const float rm=rowmax(P0,P1); resc=false; \
    { const float dl=rm; mhat=fadd_s(mhat,dl); \
      _Pragma("unroll") for(int r=0;r<16;++r){P0[r]=fsub_s(P0[r],dl);P1[r]=fsub_s(P1[r],dl);} \
      _Pragma("unroll") for(int r=0;r<16;++r)negm[r]=-mhat; asm volatile("":"+v"(negm)); } \
    _Pragma("unroll") for(int r=0;r<16;++r)P0[r]=__builtin_amdgcn_exp2f(P0[r]); }while(0)
  #define RESC() do{ if(resc){ asm volatile("s_waitcnt lgkmcnt(0)":::"memory"); \
      _Pragma("unroll") for(int d_=0;d_<2;++d_) _Pragma("unroll") for(int r=0;r<16;++r)o[d_][r]*=wsf[crow(r,hi)]; } }while(0)
  f32x16 pA0,pA1,pB0,pB1;
  typedef float f32x4_b __attribute__((ext_vector_type(4)));
  const __attribute__((address_space(3))) float*kbp=(const __attribute__((address_space(3))) float*)(shm3+LDS_KB)+4*hi;
  #define BLD4(X,B,off) do{ const f32x4_b b_=*(const __attribute__((address_space(3))) f32x4_b*)(kbq_+(off)); X[B]=b_[0];X[B+1]=b_[1];X[B+2]=b_[2];X[B+3]=b_[3]; }while(0)
  #define BLOAD(X0,X1,tt) do{ const __attribute__((address_space(3))) float*kbq_=kbp+(tt)*KVBLK; BLD4(X0,0,0);BLD4(X0,4,8);BLD4(X0,8,16);BLD4(X0,12,24);BLD4(X1,0,32);BLD4(X1,4,40);BLD4(X1,8,48);BLD4(X1,12,56); }while(0)
  int sl_prev=0,sl_cur=0,sl_next=SLOTB;
  #define ROT() do{sl_prev=sl_cur;sl_cur=sl_next;sl_next=(sl_next==(NSLOT-1)*SLOTB)?0:sl_next+SLOTB;}while(0)
  DMA_K(2,2*SLOTB);
  WAIT_BAR(3);
  BLOAD(pA0,pA1,0);
  qkt(pA0,pA1,Kbase,qr,negm,r32,hi);asm volatile("s_nop 15\n\ts_nop 7":"+v"(pA0),"+v"(pA1));CMASK(pA0,pA1,0);
  START(pA0,pA1);
  _Pragma("unroll") for(int r=0;r<16;++r)pA1[r]=__builtin_amdgcn_exp2f(pA1[r]);
  BLOAD(pB0,pB1,1);
  _Pragma("unroll") for(int r=0;r<16;++r){pB0[r]+=negm[r];pB1[r]+=negm[r];}
  WAIT_BAR(0);
  DMA_K(3,0);DMA_V(1,SLOTB);
  ROT();
  kload8(kf,kp0+sl_cur);
  WAIT_BAR(2);
  s16x4 vlo[8],vhi[8]; u32x4 pw0,pw1,pw2,pw3;
  #define PKW(P,B) cvtpk_s(P[B],P[B+1])
  #define PAF(k) __builtin_bit_cast(bf16x8,pw##k)
  #define VFR(i) (bf16x8){vlo[i][0],vlo[i][1],vlo[i][2],vlo[i][3],vhi[i][0],vhi[i][1],vhi[i][2],vhi[i][3]}
  #define PIN(x) asm volatile("":"+v"(x))
  #define MX3(a,b,c) __builtin_fmaxf(__builtin_fmaxf((a),(b)),(c))
  #define GAPA(MF,A0,A1,A2,A3,W0,W1,PW) do{ MF; sacc+=A0; sacc+=A1; sacc+=A2; sacc+=A3; PIN(sacc); W0; W1; PIN(PW); SBAR(); }while(0)
  #define EX(v) __builtin_amdgcn_exp2f(v)
  #define GAPB(MF,X,B,Y,GB) do{ MF; X[B]=EX(X[B]); X[B+1]=EX(X[B+1]); X[B+2]=EX(X[B+2]); X[B+3]=EX(X[B+3]); PIN(X); if(GB){ Y[B]+=negm[B]; Y[B+1]+=negm[B+1]; Y[B+2]+=negm[B+2]; Y[B+3]+=negm[B+3]; PIN(Y); } SBAR(); }while(0)
  #define VRD(i) do{ vlo[i]=vtr(vp_+(((i)>>2)*4096+((i)&3)*1024)); vhi[i]=vtr(vp_+(((i)>>2)*4096+((i)&3)*1024+512)); }while(0)
  #define KRD(G,j) do{ if(G){ kload2(kf,kp0+sl_next,j); SBAR(); } }while(0)
  #define STEP(C0,C1,P0,P1,t,GK,GV,GL,GB) do{ SBAR(); \
    const lds_cptr vp_=vp0+sl_prev; \
    VRD(0); SBAR(); float sacc=(P0[0]+P0[1]); \
    GAPA(C0=__builtin_amdgcn_mfma_f32_32x32x16_bf16(kf[0],qr[0],C0,0,0,0), P0[2],P0[3],P0[4],P0[5],     pw0[0]=PKW(P0,0), pw0[1]=PKW(P0,2), pw0); \
    VRD(4); SBAR(); GAPA(C1=__builtin_amdgcn_mfma_f32_32x32x16_bf16(kf[1],qr[0],C1,0,0,0), P0[6],P0[7],P0[8],P0[9],     pw0[2]=PKW(P0,4), pw0[3]=PKW(P0,6), pw0); \
    VRD(1); SBAR(); GAPA(C0=__builtin_amdgcn_mfma_f32_32x32x16_bf16(kf[2],qr[1],C0,0,0,0),   P0[10],P0[11],P0[12],P0[13], pw1[0]=PKW(P0,8), pw1[1]=PKW(P0,10), pw1); \
    VRD(5); SBAR(); GAPA(C1=__builtin_amdgcn_mfma_f32_32x32x16_bf16(kf[3],qr[1],C1,0,0,0),   P0[14],P0[15],P1[0],P1[1],   pw1[2]=PKW(P0,12),pw1[3]=PKW(P0,14), pw1); \
    VRD(2); SBAR(); GAPA(C0=__builtin_amdgcn_mfma_f32_32x32x16_bf16(kf[4],qr[2],C0,0,0,0),   P1[2],P1[3],P1[4],P1[5],     pw2[0]=PKW(P1,0), pw2[1]=PKW(P1,2), pw2); \
    VRD(6); SBAR(); GAPA(C1=__builtin_amdgcn_mfma_f32_32x32x16_bf16(kf[5],qr[2],C1,0,0,0),   P1[6],P1[7],P1[8],P1[9],     pw2[2]=PKW(P1,4), pw2[3]=PKW(P1,6), pw2); \
    VRD(3); SBAR(); GAPA(C0=__builtin_amdgcn_mfma_f32_32x32x16_bf16(kf[6],qr[3],C0,0,0,0),   P1[10],P1[11],P1[12],P1[13], pw3[0]=PKW(P1,8), pw3[1]=PKW(P1,10), pw3); \
    VRD(7); SBAR(); GAPA(C1=__builtin_amdgcn_mfma_f32_32x32x16_bf16(kf[7],qr[3],C1,0,0,0),   P1[14],P1[15],0.f,0.f,       pw3[2]=PKW(P1,12),pw3[3]=PKW(P1,14), pw3); \
    l_reg+=sacc; \
    if(GK){DMA_K((t)+3,sl_cur);} if(GV){DMA_V((t)+1,sl_next);} \
    CMASK(C0,C1,t); \
    { float a=MX3(C0[0],C0[1],C1[0]),b=MX3(C0[2],C0[3],C1[1]); a=MX3(a,C1[2],C1[3]); \
      _Pragma("unroll") for(int r=4;r<16;r+=4){a=MX3(a,C0[r],C0[r+1]);b=MX3(b,C0[r+2],C0[r+3]);a=MX3(a,C1[r],C1[r+1]);b=MX3(b,C1[r+2],C1[r+3]);} \
      float rm=__builtin_fmaxf(a,b); { auto rr=__builtin_amdgcn_permlane32_swap(__float_as_uint(rm),__float_as_uint(rm),false,false); rm=__builtin_fmaxf(__uint_as_float(rr[0]),__uint_as_float(rr[1])); } \
      resc=false; \
      if(__builtin_expect(__any(rm>(float)THRL),0)){ const float dl=__builtin_fmaxf(rm,0.f); mhat+=dl; \
        _Pragma("unroll") for(int r=0;r<16;++r){C0[r]-=dl;C1[r]-=dl;} \
        _Pragma("unroll") for(int r=0;r<16;++r)negm[r]=-mhat; asm volatile("":"+v"(negm)); \
        const float f=__builtin_amdgcn_exp2f(-dl); l_reg*=f; if(hi==0)wsf[r32]=f; resc=true; } } \
    if(GB){ BLOAD(P0,P1,(t)+1); } \
    SBAR(); \
    GAPB(o[0]=__builtin_amdgcn_mfma_f32_32x32x16_bf16(PAF(0),VFR(0),o[0],0,0,0), C0,0,P0,GB); \
    GAPB(o[1]=__builtin_amdgcn_mfma_f32_32x32x16_bf16(PAF(0),VFR(4),o[1],0,0,0), C0,4,P0,GB); \
    KRD(GL,0); GAPB(o[0]=__builtin_amdgcn_mfma_f32_32x32x16_bf16(PAF(1),VFR(1),o[0],0,0,0), C0,8,P0,GB); \
    KRD(GL,1); GAPB(o[1]=__builtin_amdgcn_mfma_f32_32x32x16_bf16(PAF(1),VFR(5),o[1],0,0,0), C0,12,P0,GB); \
    KRD(GL,2); GAPB(o[0]=__builtin_amdgcn_mfma_f32_32x32x16_bf16(PAF(2),VFR(2),o[0],0,0,0), C1,0,P1,GB); \
    KRD(GL,3); GAPB(o[1]=__builtin_amdgcn_mfma_f32_32x32x16_bf16(PAF(2),VFR(6),o[1],0,0,0), C1,4,P1,GB); \
    GAPB(o[0]=__builtin_amdgcn_mfma_f32_32x32x16_bf16(PAF(3),VFR(3),o[0],0,0,0), C1,8,P1,GB); \
    GAPB(o[1]=__builtin_amdgcn_mfma_f32_32x32x16_bf16(PAF(3),VFR(7),o[1],0,0,0), C1,12,P1,GB); \
    }while(0)
  int t=1;
  #undef CMASK
  #define CMASK(P0,P1,t) do{}while(0)
  for(;t+5<NT;t+=2){
    STEP(pB0,pB1,pA0,pA1,t,true,true,true,true);     WAIT_BAR(2); RESC(); ROT();
    STEP(pA0,pA1,pB0,pB1,t+1,true,true,true,true);   WAIT_BAR(2); RESC(); ROT();
  }
  #undef CMASK
  #define CMASK(P0,P1,t) do{int jb_=(t)-(NT-4); if(jb_>=0)cmask(P0,P1,jb_,qrel,hi);}while(0)
  #define ENDW(tt) do{ if((tt)+3<NT){WAIT_BAR(2);} else if((tt)+2<NT){WAIT_BAR(1);} else {WAIT_BAR(0);} }while(0)
  for(;t+1<NT;t+=2){
    STEP(pB0,pB1,pA0,pA1,t,(t+3<NT),(t+1<NT),(t+1<NT),(t+1<NT));       ENDW(t);   RESC(); ROT();
    STEP(pA0,pA1,pB0,pB1,t+1,(t+4<NT),(t+2<NT),(t+2<NT),(t+2<NT));     ENDW(t+1); RESC(); ROT();
  }
  STEP(pB0,pB1,pA0,pA1,NT-1,false,false,false,false); RESC();
  { float sacc=pB0[0]+pB0[1]; _Pragma("unroll") for(int r=2;r<16;++r)sacc+=pB0[r]; _Pragma("unroll") for(int r=0;r<16;++r)sacc+=pB1[r]; l_reg+=sacc;
    pw0=(u32x4){PKW(pB0,0),PKW(pB0,2),PKW(pB0,4),PKW(pB0,6)};pw1=(u32x4){PKW(pB0,8),PKW(pB0,10),PKW(pB0,12),PKW(pB0,14)};pw2=(u32x4){PKW(pB1,0),PKW(pB1,2),PKW(pB1,4),PKW(pB1,6)};pw3=(u32x4){PKW(pB1,8),PKW(pB1,10),PKW(pB1,12),PKW(pB1,14)};
    SBAR(); pv(o,vb0+sl_cur,PAF(0),PAF(1),PAF(2),PAF(3)); }
  #undef PKW
  #undef PAF
  #undef VFR
  #undef PIN
  #undef MX3
  #undef GAPA
  #undef GAPB
  #undef EX
  #undef VRD
  #undef KRD
  #undef STEP
  #undef ENDW
  {auto rr=__builtin_amdgcn_permlane32_swap(__float_as_uint(l_reg),__float_as_uint(l_reg),false,false);l_reg=__uint_as_float(rr[0])+__uint_as_float(rr[1]);}
  if(hi==0)wsf[32+r32]=l_reg;asm volatile("s_waitcnt lgkmcnt(0)":::"memory");
  float rli[16];
  #pragma unroll
  for(int r=0;r<16;++r)rli[r]=__builtin_amdgcn_rcpf(wsf[32+crow(r,hi)]);
  bf16*Ow=O+(rowbase+q0+wid*QBLK)*DM+h*D;
  { bf16*stg=(bf16*)(shm+LDS_OST)+wid*2048;
    #pragma unroll
    for(int r=0;r<16;++r){const int orow=crow(r,hi);
      #pragma unroll
      for(int d0=0;d0<2;++d0)stg[orow*64+d0*32+r32]=__float2bfloat16(o[d0][r]*rli[r]);}
    asm volatile("s_waitcnt lgkmcnt(0)":::"memory");
    #pragma unroll
    for(int i=0;i<4;++i){const int row=i*8+(lane>>3),ch=lane&7; const u32x4 v=*(const u32x4*)(stg+row*64+ch*8); ATTN_STORE16(Ow+(long)row*DM+ch*8,v);} }
  asm volatile("s_waitcnt lgkmcnt(0)\n\ts_barrier":::"memory");
  #undef BLD4
  #undef BLOAD
  #undef DMA_K
  #undef DMA_V
  #undef CMASK
  #undef START
  #undef RESC
  #undef ROT
}
constexpr int ATTN_LDS_BYTES=LDS_BYTES;
struct AttnTensors { const bf16* Q; const bf16* K; const bf16* V; bf16* O; const float* LFT; };
struct AttnUnit { int bh; int qb; };
struct StaticOrder {
  int vcu;
  __device__ __forceinline__ explicit StaticOrder(int grid,int block):vcu((block%8)*(grid/8)+block/8){}
  __device__ __forceinline__ bool next(int i,AttnUnit&u)const{ if(i>=2||vcu>=256)return false; const int s=vcu&15; u.bh=vcu>>4; u.qb=(i==0)?s:31-s; return true; }
  __device__ __forceinline__ void a_ready(const AttnUnit&)const{}
  __device__ __forceinline__ void done(const AttnUnit&)const{}
};
template<class Sched,int THRL=8> __device__ __forceinline__ void attn_phase(char*lds,const AttnTensors&T,const Sched&S){
  AttnUnit u;
  for(int i=0;S.next(i,u);++i){ S.a_ready(u); attn_unit<THRL>(u.bh/NHEAD,u.bh%NHEAD,u.qb,T.Q,T.K,T.V,T.O,T.LFT,lds); S.done(u); }
}
#undef SBAR
#undef WAIT_BAR
}
#define GAS __attribute__((address_space(1)))
#define LAS __attribute__((address_space(3)))
typedef unsigned short bf16;
typedef unsigned v4u __attribute__((ext_vector_type(4)));
typedef float f32x4 __attribute__((ext_vector_type(4)));
typedef short bf16x8 __attribute__((ext_vector_type(8)));
typedef GAS unsigned gu32;
typedef GAS unsigned long long gu64;
#define RLX_AGENT __ATOMIC_RELAXED, __HIP_MEMORY_SCOPE_AGENT
#define LDS_WAIT() asm volatile("s_waitcnt lgkmcnt(0)" ::: "memory")
#define VM_WAIT() asm volatile("s_waitcnt vmcnt(0)" ::: "memory")
__device__ __forceinline__ unsigned long long rt() { return __builtin_amdgcn_s_memrealtime(); }
__device__ __forceinline__ unsigned f2bf(float f) { unsigned u = __builtin_bit_cast(unsigned, f); return (u + 0x7fffu + ((u >> 16) & 1u)) >> 16; }
__device__ __forceinline__ unsigned pk2(float lo, float hi) { return f2bf(lo) | (f2bf(hi) << 16); }

#define XB_TMO      128
#define XB_XCNT(j)  (256  + 64 * (j))
#define XB_XSUB(j)  (1280 + 64 * (j))
#define XB_XGEN(j)  (2304 + 64 * (j))
#define XB_TOP      3328
#define XB_TOPGEN   3392
#define XCD_BAR_WORDS 3456
#define XB_SPIN_CAP (1u << 18)

__device__ __forceinline__ unsigned xb_ld(unsigned* p)              { return __hip_atomic_load(p, __ATOMIC_RELAXED, __HIP_MEMORY_SCOPE_AGENT); }
__device__ __forceinline__ unsigned xb_add(unsigned* p, unsigned v) { return __hip_atomic_fetch_add(p, v, __ATOMIC_RELAXED, __HIP_MEMORY_SCOPE_AGENT); }
__device__ __forceinline__ unsigned xb_xcc_id() { return (unsigned)__builtin_amdgcn_s_getreg((3 << 11) | 20) & 0xFu; }
#define XB_SPIN(cond, bar) do { unsigned _sp = 0; while (cond) { __builtin_amdgcn_s_sleep(1); \
    if ((++_sp & 255u) == 0u) { if (xb_ld(&(bar)[XB_TMO])) break; if (_sp > XB_SPIN_CAP) { atomicAdd(&(bar)[XB_TMO], 1u); break; } } } } while (0)

struct XcdBarrier {
    unsigned* bar; unsigned x;
    volatile LAS unsigned* st;
};

__device__ __forceinline__ XcdBarrier xcd_barrier_post(unsigned* bar, volatile LAS unsigned* st) {
    XcdBarrier b; b.bar = bar; b.x = xb_xcc_id(); b.st = st;
    if (threadIdx.x == 0) (void)xb_add(&bar[XB_XCNT(b.x)], 1u);
    return b;
}
__device__ __forceinline__ void xcd_barrier_complete(unsigned* bar, unsigned x, unsigned& nloc, unsigned& nx) {
    const unsigned G = gridDim.x * gridDim.y * gridDim.z;
    unsigned sum, cnt, mine, sp = 0u;
    for (;;) {
        sum = 0u; cnt = 0u; mine = 0u;
#pragma unroll
        for (unsigned j = 0; j < 16; ++j) { const unsigned c = xb_ld(&bar[XB_XCNT(j)]); sum += c; cnt += (c > 0u) ? 1u : 0u; mine = (j == x) ? c : mine; }
        if (sum == G) break;
        __builtin_amdgcn_s_sleep(1);
        if ((++sp & 255u) == 0u) { if (xb_ld(&bar[XB_TMO])) break; if (sp > XB_SPIN_CAP) { atomicAdd(&bar[XB_TMO], 1u); break; } }
    }
    nloc = mine > 0u ? mine : 1u; nx = cnt > 0u ? cnt : 1u;
}

__device__ __forceinline__ void xcd_barrier(const XcdBarrier& b) {
    asm volatile("s_waitcnt vmcnt(0)" ::: "memory");
    __syncthreads();
    if (threadIdx.x == 0) {
        unsigned* bar = b.bar;
        __builtin_amdgcn_s_waitcnt(0);
        unsigned nloc = b.st[0], nx = b.st[1];
        if (nloc == 0u) { xcd_barrier_complete(bar, b.x, nloc, nx); b.st[0] = nloc; b.st[1] = nx; }
        const unsigned old = xb_add(&bar[XB_XSUB(b.x)], 1u);
        const unsigned gen = old / nloc;
        if (old + 1u == (gen + 1u) * nloc) {
            __builtin_amdgcn_fence(__ATOMIC_RELEASE, "agent");
            asm volatile("s_waitcnt vmcnt(0)" ::: "memory");
            const unsigned og = xb_add(&bar[XB_TOP], 1u);
            const unsigned tg = og / nx;
            if (og + 1u == (tg + 1u) * nx) xb_add(&bar[XB_TOPGEN], 1u);
            else XB_SPIN(xb_ld(&bar[XB_TOPGEN]) == tg, bar);
            __builtin_amdgcn_fence(__ATOMIC_ACQUIRE, "agent");
            xb_add(&bar[XB_XGEN(b.x)], 1u);
            asm volatile("s_waitcnt vmcnt(0)" ::: "memory");
        } else {
            XB_SPIN(xb_ld(&bar[XB_XGEN(b.x)]) == gen, bar);
            __builtin_amdgcn_fence(__ATOMIC_ACQUIRE, "agent");
            asm volatile("s_waitcnt vmcnt(0)" ::: "memory");
        }
    }
    __syncthreads();
}
constexpr int NWAVES = 8;
constexpr int DM = 1024, TP = 8192, MP = 16384, MS = 256, MT = 16640, DEPTH = 4;
constexpr int NIN = 5888, NUP = 5632, DFF = 2816, INC = 5640, PASTL = 4096;
constexpr float EPSN = 1e-6f;
constexpr float L2E = 1.4426950408889634f;
constexpr float MEMC2 = 0.08838834764831845f * 1.4426950408889634f;

constexpr size_t O_Y = 0, O_YS = 16777216, O_KP = 17039360, O_VP = 50593792, O_LFP = 84148224, O_POOLP = 84672512, O_CONVP = 84733952,
                 O_MKP = 84824064, O_MVP = 85872640, O_KS = 86921216, O_VS = 87445504, O_LFS = 87969792, O_POOLS = 87977984, O_CONVS = 88469504, O_END = 89190400;

constexpr size_t MiB = 1u << 20;
constexpr size_t al1(size_t x) { return (x + (MiB - 1)) & ~(MiB - 1); }
constexpr size_t WS_CTL = 0, CTL_ZERO_BYTES = 1 * MiB;
constexpr size_t WE_IN = 0, WE_F = WE_IN + (size_t)NIN * 1024, WE_P = WE_F + 1024 * 512, WE_M = WE_P + 1024 * 512, WE_O = WE_M + 1024 * 512,
                 WE_UP = WE_O + 1024 * 1024, WE_DN = WE_UP + (size_t)NUP * 1024, WE_LAYER = WE_DN + (size_t)1024 * DFF;
constexpr size_t WS_W = 2 * MiB;
constexpr size_t WS_WMEM = al1(WS_W + DEPTH * WE_LAYER * 2);
constexpr size_t WS_H = al1(WS_WMEM + (size_t)4096 * 1024 * 2);
constexpr size_t WS_Q = al1(WS_H + (size_t)MT * 1024 * 2);
constexpr size_t WS_K = al1(WS_Q + (size_t)MT * 512 * 2);
constexpr size_t WS_V = al1(WS_K + (size_t)MT * 512 * 2);
constexpr size_t WS_PU = al1(WS_V + (size_t)MT * 512 * 2);
constexpr size_t WS_MQ = al1(WS_PU + (size_t)MT * 512 * 2);
constexpr size_t WS_G = al1(WS_MQ + (size_t)MT * 512 * 2);
constexpr size_t WS_LFT = al1(WS_G + (size_t)MT * 3072 * 2);
constexpr size_t WS_AO = al1(WS_LFT + (size_t)8 * MT * 4);
constexpr size_t WS_MIX = al1(WS_AO + (size_t)MT * 512 * 2);
constexpr size_t WS_MO = al1(WS_MIX + (size_t)MT * 512 * 2);
constexpr size_t WS_MF32 = al1(WS_MO + (size_t)MT * 512 * 2);
constexpr size_t WS_MRG = al1(WS_MF32 + (size_t)MT * 1024 * 4);
constexpr size_t WS_OUTF = al1(WS_MRG + (size_t)MT * 1024 * 2);
constexpr size_t WS_UP = al1(WS_OUTF + (size_t)MT * 1024 * 4);
constexpr size_t WS_HH = al1(WS_UP + (size_t)MT * NUP * 2);
constexpr size_t WS_MEMA = al1(WS_HH + (size_t)MT * DFF * 2);
constexpr size_t WS_MKP = al1(WS_MEMA + (size_t)512 * 1024 * 2);
constexpr size_t WS_MVTP = al1(WS_MKP + (size_t)4 * 512 * 512 * 2);
constexpr size_t WS_MKS = al1(WS_MVTP + (size_t)4 * 512 * 512 * 2);
constexpr size_t WS_MVTS = al1(WS_MKS + (size_t)4 * 4096 * 512 * 2);
constexpr size_t WS_SUF = al1(WS_MVTS + (size_t)4 * 4096 * 512 * 2);
constexpr size_t WS_END = al1(WS_SUF + (size_t)4 * 16 * 8 * 4096 * 4);
constexpr int CW_TMO = 0, CW_BAR = 4096;

constexpr int RING_OFF = 0, RING_BYTES = 131072;
constexpr int LDSCTL_OFF = RING_BYTES, MISC_OFF = LDSCTL_OFF + 320;
constexpr int LDS_BYTES = 147456;
static_assert(attn_body::LDS_BYTES <= RING_BYTES, "attention LDS");

struct Args { const float* in[29]; float* out; unsigned char* ws; int ph_lo, ph_hi, use_bar, pad; };

struct Frame {
    LAS unsigned char* lds;
    int tid, lane, wave, vcu, G;
    const float* const* in;
    float* out; unsigned char* ws;
};
#define WSP(T, off) ((T*)(F.ws + (off)))

__device__ __forceinline__ float wave_sum(float v) {
#pragma unroll
    for (int o = 1; o < 64; o <<= 1) v += __shfl_xor(v, o);
    return v;
}
__device__ __forceinline__ unsigned cvtpk(float lo, float hi) { return pg8::cvt_pk_bf16(lo, hi); }
__device__ __forceinline__ float bf2f(unsigned short b) { return __uint_as_float(((unsigned)b) << 16); }
__device__ __forceinline__ float bflo(unsigned w) { return __uint_as_float(w << 16); }
__device__ __forceinline__ float bfhi(unsigned w) { return __uint_as_float(w & 0xffff0000u); }

__device__ __forceinline__ int in_src_col(int n) { return n < 1536 ? n : (n < 5632 ? n + 8 : (n < 5640 ? n - 5632 + 1536 : -1)); }
__device__ __forceinline__ int up_src_col(int n) { const int pn = n >> 8, w = n & 255; return (w >> 7) * DFF + 128 * pn + (w & 127); }

__device__ __forceinline__ void tr64(const float* W, size_t ldw, int sc, const float* gain, int k0, bf16* WT, size_t ldt, int n0, LAS unsigned* scr, int lane) {
#pragma unroll
    for (int hf = 0; hf < 2; ++hf) {
        float a[32];
#pragma unroll
        for (int i = 0; i < 32; ++i) a[i] = (sc >= 0) ? W[(size_t)(k0 + 32 * hf + i) * ldw + sc] : 0.f;
        if (gain) {
#pragma unroll
            for (int i = 0; i < 32; ++i) a[i] *= gain[k0 + 32 * hf + i];
        }
#pragma unroll
        for (int i = 0; i < 16; ++i) scr[lane * 33 + 16 * hf + i] = cvtpk(a[2 * i], a[2 * i + 1]);
    }
    LDS_WAIT(); asm volatile("" ::: "memory");
    const int c = lane & 7;
#pragma unroll
    for (int j = 0; j < 8; ++j) { const int n = (lane >> 3) + 8 * j; const LAS unsigned* s = scr + n * 33 + 4 * c;
        v4u o; o.x = s[0]; o.y = s[1]; o.z = s[2]; o.w = s[3];
        *(GAS v4u*)(WT + (size_t)(n0 + n) * ldt + k0 + 8 * c) = o; }
    LDS_WAIT(); asm volatile("" ::: "memory");
}
__device__ __forceinline__ void fold_pool_item(const float* wpool, const float* ps, const float* wbr, bf16* WT, int k0, int n0, int lane) {
    const int g = k0 >> 7; const float* wp = wpool + (size_t)g * 16384 + (size_t)((k0 & 127) + lane) * 128;
    float acc[64];
#pragma unroll
    for (int i = 0; i < 64; ++i) acc[i] = 0.f;
    for (int j = 0; j < 128; ++j) {
        const float a = wp[j] * ps[128 * g + j]; const float* br = wbr + (size_t)(128 * g + j) * 1024 + n0;
#pragma unroll
        for (int i = 0; i < 64; ++i) acc[i] += a * br[i];
    }
#pragma unroll
    for (int i = 0; i < 64; ++i) WT[(size_t)(n0 + i) * 512 + k0 + lane] = (bf16)f2bf(acc[i]);
}
__device__ __forceinline__ void rms_row_to_bf16(const float* xrow, bf16* orow, int lane) {
    const GAS f32x4* xr = (const GAS f32x4*)xrow + lane;
    f32x4 v[4]; float s = 0.f;
#pragma unroll
    for (int j = 0; j < 4; ++j) { v[j] = xr[64 * j]; s += (v[j].x * v[j].x + v[j].y * v[j].y) + (v[j].z * v[j].z + v[j].w * v[j].w); }
    const float r = 1.0f / sqrtf(wave_sum(s) * (1.f / 1024.f) + EPSN);
    GAS unsigned long long* o8 = (GAS unsigned long long*)orow + lane;
#pragma unroll
    for (int j = 0; j < 4; ++j) o8[64 * j] = (unsigned long long)cvtpk(v[j].x * r, v[j].y * r) | ((unsigned long long)cvtpk(v[j].z * r, v[j].w * r) << 32);
}
__device__ __forceinline__ void suf_item(Frame& F, int lb) {
    const float* src = F.in[4] + (size_t)lb * PASTL * 8; float* dst = WSP(float, WS_SUF) + (size_t)lb * 8 * PASTL;
    LAS float* wsum = (LAS float*)(F.lds + RING_OFF);
    const int tid = F.tid, s_hi = PASTL - 1 - 8 * tid;
    float v[8][8];
    const f32x4* p = (const f32x4*)(src + (size_t)(s_hi - 7) * 8);
#pragma unroll
    for (int r = 0; r < 8; ++r) { const f32x4 a = p[2 * r], b = p[2 * r + 1]; const int k = 7 - r;
        v[k][0] = a.x; v[k][1] = a.y; v[k][2] = a.z; v[k][3] = a.w; v[k][4] = b.x; v[k][5] = b.y; v[k][6] = b.z; v[k][7] = b.w; }
    float tot[8], inc[8];
#pragma unroll
    for (int h = 0; h < 8; ++h) { float t = 0.f;
#pragma unroll
        for (int k = 0; k < 8; ++k) t += v[k][h];
        tot[h] = t; inc[h] = t; }
#pragma unroll
    for (int o = 1; o < 64; o <<= 1) {
#pragma unroll
        for (int h = 0; h < 8; ++h) { const float u = __shfl_up(inc[h], o); if (F.lane >= o) inc[h] += u; } }
    if (F.lane == 63) {
#pragma unroll
        for (int h = 0; h < 8; ++h) wsum[F.wave * 8 + h] = inc[h]; }
    __syncthreads();
#pragma unroll
    for (int h = 0; h < 8; ++h) { float pre = inc[h] - tot[h];
        for (int w = 0; w < NWAVES; ++w) { const float x = wsum[w * 8 + h]; if (w < F.wave) pre += x; }
        float x[8]; float run = pre;
#pragma unroll
        for (int k = 0; k < 8; ++k) { x[k] = run * L2E; run += v[k][h]; }
        f32x4* q = (f32x4*)(dst + (size_t)h * PASTL + (s_hi - 7));
        q[0] = (f32x4){x[7], x[6], x[5], x[4]}; q[1] = (f32x4){x[3], x[2], x[1], x[0]}; }
    __syncthreads();
}

__device__ __forceinline__ void p_prologue0(Frame& F) {
    for (int it = F.vcu; it < DEPTH * 16; it += F.G) suf_item(F, it);
    LAS unsigned* scr = (LAS unsigned*)(F.lds + RING_OFF + 1024 + F.wave * 8448);
    const int gw = F.vcu * NWAVES + F.wave, NGW = F.G * NWAVES;
    constexpr int I_IN = 16 * (NIN / 64), I_BR = 8 * 16, I_O = 16 * 16, I_UP = 16 * (NUP / 64), I_DN = (DFF / 64) * 16, I_MEM = 16 * 16, I_FOLD = 8 * 16;
    constexpr int I_LAYER = I_IN + 2 * I_BR + I_O + I_UP + I_DN + I_MEM + I_FOLD;
    constexpr int I_SMV = DEPTH * 16 * 4 * 4 * 2;
    constexpr int NITEMS = DEPTH * I_LAYER + I_SMV;
    for (int it0 = gw; it0 < NITEMS; it0 += NGW) {
        int it = it0;
        if (it >= DEPTH * I_LAYER) { it -= DEPTH * I_LAYER;
            const int lbh = it >> 3, r = it & 7, kb = r >> 1, nb = r & 1, lb = lbh >> 2, h = lbh & 3;
            tr64(F.in[8] + (size_t)lb * 256 * 512 + h * 128, 512, 64 * nb + F.lane, nullptr, 64 * kb, WSP(bf16, WS_MVTS) + (size_t)lbh * 128 * 256, 256, 64 * nb, scr, F.lane);
            continue; }
        const int l = it / I_LAYER; it -= l * I_LAYER;
        bf16* WL = WSP(bf16, WS_W) + (size_t)l * WE_LAYER;
        if (it < I_IN) { const int nblk = NIN / 64, kb = it / nblk, nb = it % nblk;
            tr64(F.in[10] + (size_t)l * 1024 * INC, INC, in_src_col(64 * nb + F.lane), F.in[21] + l * 1024, 64 * kb, WL + WE_IN, 1024, 64 * nb, scr, F.lane); continue; } it -= I_IN;
        if (it < I_BR) { const int kb = it / 16, nb = it % 16;
            tr64(F.in[17] + (size_t)l * 512 * 1024, 1024, 64 * nb + F.lane, nullptr, 64 * kb, WL + WE_F, 512, 64 * nb, scr, F.lane); continue; } it -= I_BR;
        if (it < I_BR) { const int kb = it / 16, nb = it % 16;
            tr64(F.in[19] + (size_t)l * 512 * 1024, 1024, 64 * nb + F.lane, nullptr, 64 * kb, WL + WE_M, 512, 64 * nb, scr, F.lane); continue; } it -= I_BR;
        if (it < I_O) { const int kb = it / 16, nb = it % 16;
            tr64(F.in[20] + (size_t)l * 1024 * 1024, 1024, 64 * nb + F.lane, nullptr, 64 * kb, WL + WE_O, 1024, 64 * nb, scr, F.lane); continue; } it -= I_O;
        if (it < I_UP) { const int nblk = NUP / 64, kb = it / nblk, nb = it % nblk;
            tr64(F.in[25] + (size_t)l * 1024 * NUP, NUP, up_src_col(64 * nb + F.lane), F.in[23] + l * 1024, 64 * kb, WL + WE_UP, 1024, 64 * nb, scr, F.lane); continue; } it -= I_UP;
        if (it < I_DN) { const int kb = it / 16, nb = it % 16;
            tr64(F.in[28] + (size_t)l * DFF * 1024, 1024, 64 * nb + F.lane, nullptr, 64 * kb, WL + WE_DN, DFF, 64 * nb, scr, F.lane); continue; } it -= I_DN;
        if (it < I_MEM) { const int kb = it / 16, nb = it % 16;
            tr64(F.in[15] + (size_t)l * 1024 * 1024, 1024, 64 * nb + F.lane, F.in[16] + l * 1024, 64 * kb, WSP(bf16, WS_WMEM) + (size_t)l * 1024 * 1024, 1024, 64 * nb, scr, F.lane); continue; } it -= I_MEM;
        { const int kb = it / 16, nb = it % 16;
          fold_pool_item(F.in[13] + (size_t)l * 4 * 16384, F.in[14] + l * 512, F.in[18] + (size_t)l * 512 * 1024, WL + WE_P, 64 * kb, 64 * nb, F.lane); }
    }
    for (int m = gw; m < MT + 512; m += NGW) {
        if (m < MP) rms_row_to_bf16(F.in[0] + (size_t)m * 1024, WSP(bf16, WS_H) + (size_t)m * 1024, F.lane);
        else if (m < MT) rms_row_to_bf16(F.in[1] + (size_t)(m - MP) * 1024, WSP(bf16, WS_H) + (size_t)m * 1024, F.lane);
        else rms_row_to_bf16(F.in[9] + (size_t)(m - MT) * 1024, WSP(bf16, WS_MEMA) + (size_t)(m - MT) * 1024, F.lane);
    }
    { const size_t n8 = (size_t)DEPTH * 4096 * 512 / 8; const f32x4* s = (const f32x4*)F.in[7]; v4u* d = WSP(v4u, WS_MKS);
      for (size_t i = (size_t)gw * 64 + F.lane; i < n8; i += (size_t)NGW * 64) { const f32x4 a = s[2 * i], b = s[2 * i + 1];
          v4u o; o.x = cvtpk(a.x, a.y); o.y = cvtpk(a.z, a.w); o.z = cvtpk(b.x, b.y); o.w = cvtpk(b.z, b.w); d[i] = o; } }
}

#define EPI_LOOP_BEGIN \
    _Pragma("unroll") for (int ai = 0; ai < 2; ++ai) _Pragma("unroll") for (int m = 0; m < 4; ++m) { const int row = u.pm * 256 + ai * 128 + wr * 64 + m * 16 + fr; \
    _Pragma("unroll") for (int bj = 0; bj < 2; ++bj) { const int c8 = u.pn * 256 + bj * 128 + wc * 32 + 8 * fq; f32x4 v0 = acc[ai][bj][m][0], v1 = acc[ai][bj][m][1];
#define EPI_LOOP_END } }
__device__ __forceinline__ v4u pack8(f32x4 v0, f32x4 v1) { v4u w; w.x = cvtpk(v0[0], v0[1]); w.y = cvtpk(v0[2], v0[3]); w.z = cvtpk(v1[0], v1[1]); w.w = cvtpk(v1[2], v1[3]); return w; }
__device__ __forceinline__ float sigmoidf_(float x) { return 1.0f / (1.0f + __expf(-x)); }
__device__ __forceinline__ float logsigmoidf_(float x) { return fminf(x, 0.f) - log1pf(__expf(-fabsf(x))); }

struct EpiIn {
    static constexpr bool PERM = true, AFTER_DRAIN = false;
    unsigned char* ws; float* out; const float* bgate; const float* bforget; int l;
    __device__ __forceinline__ void operator()(const f32x4 (&acc)[2][2][4][2], const pg8::Unit& u, int wr, int wc, int fr, int fq) const {
        const int pn = u.pn;
        if (pn < 2) { bf16* Q = (bf16*)(ws + WS_Q);
            EPI_LOOP_BEGIN v0 = v0 * attn_body::C2; v1 = v1 * attn_body::C2; *(v4u*)(Q + (size_t)row * 512 + c8) = pack8(v0, v1); EPI_LOOP_END
        } else if (pn < 6) { const bool isk = pn < 4; bf16* B = (bf16*)(ws + (isk ? WS_K : WS_V));
            EPI_LOOP_BEGIN const int c = c8 - (isk ? 512 : 1024); *(v4u*)(B + (size_t)row * 512 + c) = pack8(v0, v1);
                float* o = (row < MP) ? out + (isk ? O_KP : O_VP) + (size_t)l * 8388608 + (size_t)row * 512 + c : out + (isk ? O_KS : O_VS) + (size_t)l * 131072 + (size_t)(row - MP) * 512 + c;
                *(f32x4*)o = v0; *(f32x4*)(o + 4) = v1; EPI_LOOP_END
        } else if (pn < 8) { bf16* B = (bf16*)(ws + WS_PU);
            EPI_LOOP_BEGIN const int c = c8 - 1536; *(v4u*)(B + (size_t)row * 512 + c) = pack8(v0, v1);
                if (row < MP) { const int t = row & (TP - 1); if (t >= TP - 15) { float* o = out + O_POOLP + ((size_t)(l * 2 + (row >> 13)) * 15 + (t - (TP - 15))) * 512 + c; *(f32x4*)o = v0; *(f32x4*)(o + 4) = v1; } }
                else { const int rs = row - MP, ts = rs & 15; if (ts >= 1) { float* o = out + O_POOLS + ((size_t)(l * 16 + (rs >> 4)) * 15 + (ts - 1)) * 512 + c; *(f32x4*)o = v0; *(f32x4*)(o + 4) = v1; } }
            EPI_LOOP_END
        } else if (pn < 10) { bf16* B = (bf16*)(ws + WS_MQ);
            EPI_LOOP_BEGIN v0 = v0 * MEMC2; v1 = v1 * MEMC2; *(v4u*)(B + (size_t)row * 512 + (c8 - 2048)) = pack8(v0, v1); EPI_LOOP_END
        } else if (pn < 22) { bf16* B = (bf16*)(ws + WS_G);
            EPI_LOOP_BEGIN const int c = c8 - 2560; const f32x4 b0 = *(const f32x4*)(bgate + c), b1 = *(const f32x4*)(bgate + c + 4);
                f32x4 g0, g1;
#pragma unroll
                for (int e = 0; e < 4; ++e) { g0[e] = sigmoidf_(v0[e] + b0[e]); g1[e] = sigmoidf_(v1[e] + b1[e]); }
                *(v4u*)(B + (size_t)row * 3072 + c) = pack8(g0, g1); EPI_LOOP_END
        } else { float* LFT = (float*)(ws + WS_LFT);
            if (wc == 0 && fq == 0) {
#pragma unroll
                for (int ai = 0; ai < 2; ++ai)
#pragma unroll
                    for (int m = 0; m < 4; ++m) { const int row = u.pm * 256 + ai * 128 + wr * 64 + m * 16 + fr; const f32x4 v0 = acc[ai][0][m][0], v1 = acc[ai][0][m][1];
                        f32x4 f0, f1;
#pragma unroll
                        for (int e = 0; e < 4; ++e) { f0[e] = logsigmoidf_(v0[e] + bforget[e]); f1[e] = logsigmoidf_(v1[e] + bforget[4 + e]); }
#pragma unroll
                        for (int e = 0; e < 4; ++e) { LFT[(size_t)e * MT + row] = f0[e]; LFT[(size_t)(4 + e) * MT + row] = f1[e]; }
                        float* o = (row < MP) ? out + O_LFP + (size_t)l * 131072 + (size_t)row * 8 : out + O_LFS + (size_t)l * 2048 + (size_t)(row - MP) * 8;
                        *(f32x4*)o = f0; *(f32x4*)(o + 4) = f1; }
            }
        }
    }
};
struct EpiMemKV {
    static constexpr bool PERM = true, AFTER_DRAIN = false;
    unsigned char* ws; float* out;
    __device__ __forceinline__ void operator()(const f32x4 (&acc)[2][2][4][2], const pg8::Unit& u, int wr, int wc, int fr, int fq) const {
        const int l = u.pn >> 2; const bool isk = (u.pn & 3) < 2;
        bf16* MK = (bf16*)(ws + WS_MKP) + (size_t)l * 512 * 512; bf16* MVT = (bf16*)(ws + WS_MVTP) + (size_t)l * 512 * 512;
        EPI_LOOP_BEGIN const int c = (c8 & 1023) - (isk ? 0 : 512);
            float* o = out + (isk ? O_MKP : O_MVP) + (size_t)l * 262144 + (size_t)row * 512 + c; *(f32x4*)o = v0; *(f32x4*)(o + 4) = v1;
            if (isk) *(v4u*)(MK + (size_t)row * 512 + c) = pack8(v0, v1);
            else { const int b = row >> 8, key = row & 255, h = c >> 7, d = c & 127; bf16* p = MVT + ((size_t)(b * 4 + h) * 128 + d) * 256 + key;
#pragma unroll
                for (int e = 0; e < 4; ++e) { p[(size_t)e * 256] = (bf16)f2bf(v0[e]); p[(size_t)(4 + e) * 256] = (bf16)f2bf(v1[e]); } }
        EPI_LOOP_END
    }
};
template <int SEG> struct EpiBranch {
    static constexpr bool PERM = true, AFTER_DRAIN = false;
    unsigned char* ws;
    __device__ __forceinline__ void operator()(const f32x4 (&acc)[2][2][4][2], const pg8::Unit& u, int wr, int wc, int fr, int fq) const {
        const bf16* G = (const bf16*)(ws + WS_G); float* MF = (float*)(ws + WS_MF32); bf16* MG = (bf16*)(ws + WS_MRG);
        EPI_LOOP_BEGIN const v4u gw = *(const v4u*)(G + (size_t)row * 3072 + SEG * 1024 + c8);
            v0[0] *= bflo(gw.x); v0[1] *= bfhi(gw.x); v0[2] *= bflo(gw.y); v0[3] *= bfhi(gw.y); v1[0] *= bflo(gw.z); v1[1] *= bfhi(gw.z); v1[2] *= bflo(gw.w); v1[3] *= bfhi(gw.w);
            float* mp = MF + (size_t)row * 1024 + c8;
            if (SEG > 0) { v0 = v0 + *(const f32x4*)mp; v1 = v1 + *(const f32x4*)(mp + 4); }
            if (SEG < 2) { *(f32x4*)mp = v0; *(f32x4*)(mp + 4) = v1; }
            else *(v4u*)(MG + (size_t)row * 1024 + c8) = pack8(v0, v1);
        EPI_LOOP_END
    }
};
struct EpiF32 {
    static constexpr bool PERM = true, AFTER_DRAIN = false;
    float* O;
    __device__ __forceinline__ void operator()(const f32x4 (&acc)[2][2][4][2], const pg8::Unit& u, int wr, int wc, int fr, int fq) const {
        EPI_LOOP_BEGIN float* o = O + (size_t)row * 1024 + c8; *(f32x4*)o = v0; *(f32x4*)(o + 4) = v1; EPI_LOOP_END
    }
};
struct EpiUp {
    static constexpr bool PERM = true, AFTER_DRAIN = false;
    unsigned char* ws; float* out; int l;
    __device__ __forceinline__ void operator()(const f32x4 (&acc)[2][2][4][2], const pg8::Unit& u, int wr, int wc, int fr, int fq) const {
        bf16* U = (bf16*)(ws + WS_UP);
        EPI_LOOP_BEGIN *(v4u*)(U + (size_t)row * NUP + c8) = pack8(v0, v1);
            const int oc = bj * DFF + 128 * u.pn + wc * 32 + 8 * fq;
            if (row < MP) { const int t = row & (TP - 1); if (t >= TP - 2) { float* o = out + O_CONVP + ((size_t)(l * 2 + (row >> 13)) * 2 + (t - (TP - 2))) * NUP + oc; *(f32x4*)o = v0; *(f32x4*)(o + 4) = v1; } }
            else { const int rs = row - MP, ts = rs & 15; if (ts >= 14) { float* o = out + O_CONVS + ((size_t)(l * 16 + (rs >> 4)) * 2 + (ts - 14)) * NUP + oc; *(f32x4*)o = v0; *(f32x4*)(o + 4) = v1; } }
        EPI_LOOP_END
    }
};

__device__ __forceinline__ void p_postnorm(Frame& F, int l, const float* gpost, bool first_read_input, bool write_h) {
    const int gw = F.vcu * NWAVES + F.wave, NGW = F.G * NWAVES;
    const float* OF = WSP(float, WS_OUTF); bf16* H = WSP(bf16, WS_H);
    f32x4 gv[4];
#pragma unroll
    for (int j = 0; j < 4; ++j) gv[j] = ((const f32x4*)gpost)[F.lane + 64 * j];
    for (int m = gw; m < MT; m += NGW) {
        const float* xin = first_read_input ? (m < MP ? F.in[0] + (size_t)m * 1024 : F.in[1] + (size_t)(m - MP) * 1024) : F.out + (size_t)m * 1024;
        const GAS f32x4* xr = (const GAS f32x4*)xin + F.lane; const GAS f32x4* orow = (const GAS f32x4*)(OF + (size_t)m * 1024) + F.lane;
        f32x4 x[4], o[4]; float s = 0.f;
#pragma unroll
        for (int j = 0; j < 4; ++j) { x[j] = xr[64 * j]; o[j] = orow[64 * j]; s += (o[j].x * o[j].x + o[j].y * o[j].y) + (o[j].z * o[j].z + o[j].w * o[j].w); }
        const float r = 1.0f / sqrtf(wave_sum(s) * (1.f / 1024.f) + EPSN); float s2 = 0.f;
#pragma unroll
        for (int j = 0; j < 4; ++j) { x[j] = x[j] + o[j] * r * gv[j]; s2 += (x[j].x * x[j].x + x[j].y * x[j].y) + (x[j].z * x[j].z + x[j].w * x[j].w); }
        GAS f32x4* xo = (GAS f32x4*)(F.out + (size_t)m * 1024) + F.lane;
#pragma unroll
        for (int j = 0; j < 4; ++j) xo[64 * j] = x[j];
        if (write_h) { const float r2 = 1.0f / sqrtf(wave_sum(s2) * (1.f / 1024.f) + EPSN);
            GAS unsigned long long* o8 = (GAS unsigned long long*)(H + (size_t)m * 1024) + F.lane;
#pragma unroll
            for (int j = 0; j < 4; ++j) o8[64 * j] = (unsigned long long)cvtpk(x[j].x * r2, x[j].y * r2) | ((unsigned long long)cvtpk(x[j].z * r2, x[j].w * r2) << 32); }
    }
}
__device__ __forceinline__ float gelu_tanh(float x) { const float u = 0.7978845608028654f * (x + 0.044715f * x * x * x); const float e = __expf(2.f * u); const float t = 1.f - 2.f / (e + 1.f); return 0.5f * x * (1.f + t); }
__device__ __forceinline__ void p_conv(Frame& F, int l) {
    const int gw = F.vcu * NWAVES + F.wave, NGW = F.G * NWAVES;
    const bf16* U = WSP(bf16, WS_UP); bf16* HH = WSP(bf16, WS_HH);
    const float* cw = F.in[26] + (size_t)l * 3 * NUP; const float* cb = F.in[27] + (size_t)l * NUP; const float* sc = F.in[6] + (size_t)l * 16 * 2 * NUP;
    constexpr int NJB = DFF / 256, NITEMS = (MT / 16) * NJB;
    for (int it = gw; it < NITEMS; it += NGW) {
        const int rb = it / NJB, jb = it % NJB; const int j0 = 256 * jb + 4 * F.lane;
        const int pc = 256 * (j0 >> 7) + (j0 & 127);
        f32x4 wg[3], wv[3];
#pragma unroll
        for (int k = 0; k < 3; ++k) { wg[k] = *(const f32x4*)(cw + (size_t)k * NUP + j0); wv[k] = *(const f32x4*)(cw + (size_t)k * NUP + DFF + j0); }
        const f32x4 bg = *(const f32x4*)(cb + j0), bv = *(const f32x4*)(cb + DFF + j0);
        const int row0 = 16 * rb;
        f32x4 g2, g1, v2, v1;
        auto ld = [&](int row, f32x4& g, f32x4& v) { const uint2 a = *(const uint2*)(U + (size_t)row * NUP + pc), b = *(const uint2*)(U + (size_t)row * NUP + pc + 128);
            g = (f32x4){bflo(a.x), bfhi(a.x), bflo(a.y), bfhi(a.y)}; v = (f32x4){bflo(b.x), bfhi(b.x), bflo(b.y), bfhi(b.y)}; };
        const bool seq_start = (row0 < MP) ? ((row0 & (TP - 1)) == 0) : true;
        if (!seq_start) { ld(row0 - 2, g2, v2); ld(row0 - 1, g1, v1); }
        else if (row0 < MP) { g2 = g1 = v2 = v1 = (f32x4){0.f, 0.f, 0.f, 0.f}; }
        else { const float* h = sc + (size_t)((row0 - MP) >> 4) * 2 * NUP; g2 = *(const f32x4*)(h + j0); v2 = *(const f32x4*)(h + DFF + j0); g1 = *(const f32x4*)(h + NUP + j0); v1 = *(const f32x4*)(h + NUP + DFF + j0); }
#pragma unroll 4
        for (int r = 0; r < 16; ++r) { f32x4 g0, v0; ld(row0 + r, g0, v0);
            const f32x4 zg = g2 * wg[0] + g1 * wg[1] + g0 * wg[2] + bg, zv = v2 * wv[0] + v1 * wv[1] + v0 * wv[2] + bv;
            uint2 o; o.x = cvtpk(gelu_tanh(zg[0]) * zv[0], gelu_tanh(zg[1]) * zv[1]); o.y = cvtpk(gelu_tanh(zg[2]) * zv[2], gelu_tanh(zg[3]) * zv[3]);
            *(uint2*)(HH + (size_t)(row0 + r) * DFF + j0) = o;
            g2 = g1; v2 = v1; g1 = g0; v1 = v0; }
    }
}
__device__ __forceinline__ void p_poolmix(Frame& F, int l) {
    const int gw = F.vcu * NWAVES + F.wave, NGW = F.G * NWAVES;
    const bf16* PU = WSP(bf16, WS_PU); bf16* MIX = WSP(bf16, WS_MIX);
    const int c0 = 8 * F.lane, w = 2 << (F.lane >> 4);
    for (int it = gw; it < MT / 16; it += NGW) {
        const int row0 = 16 * it; const bool samp = row0 >= MP; const int tb0 = samp ? 0 : (row0 & (TP - 1));
        const float* hist = samp ? F.in[5] + ((size_t)(l * 16 + ((row0 - MP) >> 4)) * 15) * 512 + c0 : nullptr;
        auto ldu = [&](int t, float (&u)[8]) {
            if (t >= 0) { const v4u a = *(const v4u*)(PU + (size_t)(row0 - tb0 + t) * 512 + c0);
                u[0] = bflo(a.x); u[1] = bfhi(a.x); u[2] = bflo(a.y); u[3] = bfhi(a.y); u[4] = bflo(a.z); u[5] = bfhi(a.z); u[6] = bflo(a.w); u[7] = bfhi(a.w); }
            else if (samp) { const f32x4 a = *(const f32x4*)(hist + (size_t)(15 + t) * 512), b = *(const f32x4*)(hist + (size_t)(15 + t) * 512 + 4);
                u[0] = a.x; u[1] = a.y; u[2] = a.z; u[3] = a.w; u[4] = b.x; u[5] = b.y; u[6] = b.z; u[7] = b.w; }
            else {
#pragma unroll
                for (int e = 0; e < 8; ++e) u[e] = 0.f; } };
        float s[8];
#pragma unroll
        for (int e = 0; e < 8; ++e) s[e] = 0.f;
        for (int j = 1; j < w; ++j) { float u[8]; ldu(tb0 - j, u);
#pragma unroll
            for (int e = 0; e < 8; ++e) s[e] += u[e]; }
        for (int r = 0; r < 16; ++r) { const int t = tb0 + r; float u[8], uo[8]; ldu(t, u);
#pragma unroll
            for (int e = 0; e < 8; ++e) s[e] += u[e];
            const float inv = 1.0f / (samp ? (float)w : (float)((t + 1 < w) ? t + 1 : w));
            v4u o; o.x = cvtpk(s[0] * inv - u[0], s[1] * inv - u[1]); o.y = cvtpk(s[2] * inv - u[2], s[3] * inv - u[3]); o.z = cvtpk(s[4] * inv - u[4], s[5] * inv - u[5]); o.w = cvtpk(s[6] * inv - u[6], s[7] * inv - u[7]);
            *(v4u*)(MIX + (size_t)(row0 + r) * 512 + c0) = o;
            ldu(t - w + 1, uo);
#pragma unroll
            for (int e = 0; e < 8; ++e) s[e] -= uo[e]; }
    }
}

typedef float f32x16 __attribute__((ext_vector_type(16)));
__device__ __forceinline__ void memattn_item(const bf16* Qp  , int nvalid, const bf16* Kh  , const bf16* VT  , bf16* Op, int lane) {
    const int r32 = lane & 31, hi = lane >> 5; const int qrow = r32 < nvalid ? r32 : nvalid - 1;
    bf16x8 qf[8];
#pragma unroll
    for (int s = 0; s < 8; ++s) qf[s] = *(const bf16x8*)(Qp + (size_t)qrow * 512 + 16 * s + 8 * hi);
    f32x16 o[4];
#pragma unroll
    for (int d = 0; d < 4; ++d) o[d] = (f32x16){};
    float mrun = -1e30f, lrun = 0.f;
    for (int t = 0; t < 4; ++t) {
        f32x16 p[2];
#pragma unroll
        for (int blk = 0; blk < 2; ++blk) { p[blk] = (f32x16){}; const bf16* kp = Kh + (size_t)(64 * t + 32 * blk + r32) * 512 + 8 * hi;
#pragma unroll
            for (int s = 0; s < 8; ++s) { const bf16x8 a = *(const bf16x8*)(kp + 16 * s); p[blk] = __builtin_amdgcn_mfma_f32_32x32x16_bf16(a, qf[s], p[blk], 0, 0, 0); } }
        float mx = p[0][0];
#pragma unroll
        for (int r = 0; r < 16; ++r) { mx = fmaxf(mx, p[0][r]); mx = fmaxf(mx, p[1][r]); }
        mx = fmaxf(mx, __shfl_xor(mx, 32));
        const float mnew = fmaxf(mrun, mx), alpha = __builtin_amdgcn_exp2f(mrun - mnew); mrun = mnew;
        float ls = 0.f;
#pragma unroll
        for (int blk = 0; blk < 2; ++blk)
#pragma unroll
            for (int r = 0; r < 16; ++r) { p[blk][r] = __builtin_amdgcn_exp2f(p[blk][r] - mnew); ls += p[blk][r]; }
        lrun = lrun * alpha + ls;
#pragma unroll
        for (int d = 0; d < 4; ++d) o[d] = o[d] * alpha;
#pragma unroll
        for (int blk = 0; blk < 2; ++blk)
#pragma unroll
            for (int s2 = 0; s2 < 2; ++s2) {
                v4u pw; pw.x = cvtpk(p[blk][8 * s2 + 0], p[blk][8 * s2 + 1]); pw.y = cvtpk(p[blk][8 * s2 + 2], p[blk][8 * s2 + 3]); pw.z = cvtpk(p[blk][8 * s2 + 4], p[blk][8 * s2 + 5]); pw.w = cvtpk(p[blk][8 * s2 + 6], p[blk][8 * s2 + 7]);
                const bf16x8 pb = __builtin_bit_cast(bf16x8, pw);
                const int kbase = 64 * t + 32 * blk + 16 * s2 + 4 * hi;
#pragma unroll
                for (int d = 0; d < 4; ++d) { const bf16* vp = VT + (size_t)(32 * d + r32) * 256 + kbase;
                    const uint2 a0 = *(const uint2*)vp, a1 = *(const uint2*)(vp + 8); v4u aw; aw.x = a0.x; aw.y = a0.y; aw.z = a1.x; aw.w = a1.y;
                    o[d] = __builtin_amdgcn_mfma_f32_32x32x16_bf16(__builtin_bit_cast(bf16x8, aw), pb, o[d], 0, 0, 0); }
            }
    }
    lrun += __shfl_xor(lrun, 32);
    const float inv = 1.0f / lrun;
    if (r32 < nvalid) {
#pragma unroll
        for (int d = 0; d < 4; ++d)
#pragma unroll
            for (int a = 0; a < 4; ++a) { uint2 w; w.x = cvtpk(o[d][4 * a] * inv, o[d][4 * a + 1] * inv); w.y = cvtpk(o[d][4 * a + 2] * inv, o[d][4 * a + 3] * inv);
                *(uint2*)(Op + (size_t)r32 * 512 + 32 * d + 8 * a + 4 * hi) = w; }
    }
}

typedef float f32x4s __attribute__((ext_vector_type(4)));
__device__ __forceinline__ void fox_sample_item(Frame& F, int l, int b, int h) {
    const int lane = F.lane, wv = F.wave, c = lane & 15, g = lane >> 4;
    const bf16* Qb = WSP(bf16, WS_Q) + (size_t)(MP + 16 * b) * 512 + h * 64;
    const bf16* Kn = WSP(bf16, WS_K) + (size_t)(MP + 16 * b) * 512 + h * 64;
    const bf16* Vn = WSP(bf16, WS_V) + (size_t)(MP + 16 * b) * 512 + h * 64;
    const float* Kc = F.in[2] + ((size_t)(l * 16 + b) * PASTL) * 512 + h * 64;
    const float* Vc = F.in[3] + ((size_t)(l * 16 + b) * PASTL) * 512 + h * 64;
    const float* suf = WSP(float, WS_SUF) + ((size_t)(l * 16 + b) * 8 + h) * PASTL;
    bf16x8 qf[2];
#pragma unroll
    for (int ks = 0; ks < 2; ++ks) qf[ks] = *(const bf16x8*)(Qb + (size_t)c * 512 + 32 * ks + 8 * g);
    f32x4s acc[4];
#pragma unroll
    for (int d = 0; d < 4; ++d) acc[d] = (f32x4s){0.f, 0.f, 0.f, 0.f};
    float mrun = -1e30f, lrun = 0.f;
    struct Stage { f32x4s k[4][2]; float v[4][8]; f32x4s bA, bB; };
    const int koff = c * 512 + 8 * g, voff = 4 * g * 512 + c;
    auto load = [&](int s0, Stage& S) {
#pragma unroll
        for (int kb = 0; kb < 2; ++kb)
#pragma unroll
            for (int ks = 0; ks < 2; ++ks) { const float* pu = Kc + (size_t)(s0 + 16 * kb) * 512 + 32 * ks; S.k[kb * 2 + ks][0] = *(const f32x4s*)(pu + koff); S.k[kb * 2 + ks][1] = *(const f32x4s*)(pu + koff + 4); }
#pragma unroll
        for (int d = 0; d < 4; ++d)
#pragma unroll
            for (int j = 0; j < 8; ++j) { const float* pu = Vc + (size_t)(s0 + (j < 4 ? j : 16 + (j - 4))) * 512 + 16 * d; S.v[d][j] = pu[voff]; }
        S.bA = *(const f32x4s*)(suf + s0 + 4 * g); S.bB = *(const f32x4s*)(suf + s0 + 16 + 4 * g);
    };
    auto softmax_pv = [&](f32x4s sA, f32x4s sB, const bf16x8 (&vf)[4]) {
        float mx = fmaxf(fmaxf(fmaxf(sA[0], sA[1]), fmaxf(sA[2], sA[3])), fmaxf(fmaxf(sB[0], sB[1]), fmaxf(sB[2], sB[3])));
        mx = fmaxf(mx, __shfl_xor(mx, 16)); mx = fmaxf(mx, __shfl_xor(mx, 32));
        const float mnew = fmaxf(mrun, mx), alpha = __builtin_amdgcn_exp2f(mrun - mnew); mrun = mnew;
        float ls = 0.f;
#pragma unroll
        for (int r = 0; r < 4; ++r) { sA[r] = __builtin_amdgcn_exp2f(sA[r] - mnew); sB[r] = __builtin_amdgcn_exp2f(sB[r] - mnew); ls += sA[r] + sB[r]; }
        lrun = lrun * alpha + ls;
        v4u pw; pw.x = cvtpk(sA[0], sA[1]); pw.y = cvtpk(sA[2], sA[3]); pw.z = cvtpk(sB[0], sB[1]); pw.w = cvtpk(sB[2], sB[3]);
        const bf16x8 pb = __builtin_bit_cast(bf16x8, pw);
#pragma unroll
        for (int d = 0; d < 4; ++d) { acc[d] = acc[d] * alpha; acc[d] = __builtin_amdgcn_mfma_f32_16x16x32_bf16(vf[d], pb, acc[d], 0, 0, 0); }
    };
    auto compute = [&](const Stage& S) {
        f32x4s sA = S.bA, sB = S.bB;
#pragma unroll
        for (int ks = 0; ks < 2; ++ks) {
            { const f32x4s a = S.k[ks][0], b2 = S.k[ks][1]; v4u w; w.x = cvtpk(a[0], a[1]); w.y = cvtpk(a[2], a[3]); w.z = cvtpk(b2[0], b2[1]); w.w = cvtpk(b2[2], b2[3]);
              sA = __builtin_amdgcn_mfma_f32_16x16x32_bf16(__builtin_bit_cast(bf16x8, w), qf[ks], sA, 0, 0, 0); }
            { const f32x4s a = S.k[2 + ks][0], b2 = S.k[2 + ks][1]; v4u w; w.x = cvtpk(a[0], a[1]); w.y = cvtpk(a[2], a[3]); w.z = cvtpk(b2[0], b2[1]); w.w = cvtpk(b2[2], b2[3]);
              sB = __builtin_amdgcn_mfma_f32_16x16x32_bf16(__builtin_bit_cast(bf16x8, w), qf[ks], sB, 0, 0, 0); }
        }
        bf16x8 vf[4];
#pragma unroll
        for (int d = 0; d < 4; ++d) { v4u w; w.x = cvtpk(S.v[d][0], S.v[d][1]); w.y = cvtpk(S.v[d][2], S.v[d][3]); w.z = cvtpk(S.v[d][4], S.v[d][5]); w.w = cvtpk(S.v[d][6], S.v[d][7]); vf[d] = __builtin_bit_cast(bf16x8, w); }
        softmax_pv(sA, sB, vf);
    };
    const int sbeg = 512 * wv;
    Stage S0, S1;
    load(sbeg, S0);
    for (int i = 0; i < 16; i += 2) {
        load(sbeg + 32 * (i + 1), S1);
        compute(S0);
        if (i + 2 < 16) load(sbeg + 32 * (i + 2), S0);
        compute(S1);
    }
    if (wv == 7) {
        const float* lfn = WSP(float, WS_LFT) + (size_t)h * MT + MP + 16 * b;
        float cum = lfn[c];
#pragma unroll
        for (int o = 1; o < 16; o <<= 1) { const float u = __shfl_up(cum, o, 16); if (c >= o) cum += u; }
        f32x4s sA, sB;
#pragma unroll
        for (int r = 0; r < 4; ++r) { sA[r] = -L2E * __shfl(cum, 4 * g + r, 16); sB[r] = 0.f; }
#pragma unroll
        for (int ks = 0; ks < 2; ++ks) { const bf16x8 a = *(const bf16x8*)(Kn + (size_t)c * 512 + 32 * ks + 8 * g); sA = __builtin_amdgcn_mfma_f32_16x16x32_bf16(a, qf[ks], sA, 0, 0, 0); }
#pragma unroll
        for (int r = 0; r < 4; ++r) { if (4 * g + r > c) sA[r] = -INFINITY; sB[r] = -INFINITY; }
        bf16x8 vf[4];
#pragma unroll
        for (int d = 0; d < 4; ++d) { v4u w; const bf16* vp = Vn + 16 * d + c;
            w.x = (unsigned)vp[(size_t)(4 * g + 0) * 512] | ((unsigned)vp[(size_t)(4 * g + 1) * 512] << 16); w.y = (unsigned)vp[(size_t)(4 * g + 2) * 512] | ((unsigned)vp[(size_t)(4 * g + 3) * 512] << 16); w.z = 0u; w.w = 0u;
            vf[d] = __builtin_bit_cast(bf16x8, w); }
        softmax_pv(sA, sB, vf);
    }
    lrun += __shfl_xor(lrun, 16); lrun += __shfl_xor(lrun, 32);
    LAS float* part = (LAS float*)(F.lds + RING_OFF) + wv * 1088;
    if (g == 0) { part[c] = mrun; part[16 + c] = lrun; }
#pragma unroll
    for (int d = 0; d < 4; ++d)
#pragma unroll
        for (int r = 0; r < 4; ++r) part[64 + (16 * d + 4 * g + r) * 16 + c] = acc[d][r];
    __syncthreads();
    { const LAS float* P = (const LAS float*)(F.lds + RING_OFF); const int q = F.tid & 15, d0 = F.tid >> 4;
      float ms = -1e30f;
#pragma unroll
      for (int w = 0; w < 8; ++w) ms = fmaxf(ms, P[w * 1088 + q]);
      float L = 0.f, o0 = 0.f, o1 = 0.f;
#pragma unroll
      for (int w = 0; w < 8; ++w) { const float f = __builtin_amdgcn_exp2f(P[w * 1088 + q] - ms); L += f * P[w * 1088 + 16 + q]; o0 += f * P[w * 1088 + 64 + d0 * 16 + q]; o1 += f * P[w * 1088 + 64 + (d0 + 32) * 16 + q]; }
      bf16* AO = WSP(bf16, WS_AO) + (size_t)(MP + 16 * b + q) * 512 + h * 64;
      AO[d0] = (bf16)f2bf(o0 / L); AO[d0 + 32] = (bf16)f2bf(o1 / L); }
    __syncthreads();
}

__device__ __forceinline__ void p_attn(Frame& F, int l, char* ldsg, int Gl, int bxl) {
    { const attn_body::AttnTensors AT{(const attn_body::bf16*)WSP(bf16, WS_Q), (const attn_body::bf16*)WSP(bf16, WS_K), (const attn_body::bf16*)WSP(bf16, WS_V), (attn_body::bf16*)WSP(bf16, WS_AO), WSP(float, WS_LFT)};
      const attn_body::StaticOrder S(Gl, bxl);
#ifndef SKIP_FOXP
      attn_body::attn_phase<attn_body::StaticOrder>(ldsg + RING_OFF, AT, S);
#endif
    }
    __syncthreads();
#ifndef SKIP_FOXS
    for (int it = F.vcu; it < 128; it += F.G) fox_sample_item(F, l, it >> 3, it & 7);
#endif
#ifndef SKIP_MEMA
    { const int gw = F.vcu * NWAVES + F.wave, NGW = F.G * NWAVES;
      for (int it = gw; it < 2048 + 64; it += NGW) {
          if (it < 2048) { const int bh = it >> 8, rb = it & 255, b = bh >> 2, h = bh & 3; const size_t row0 = (size_t)b * TP + 32 * rb;
              memattn_item(WSP(bf16, WS_MQ) + row0 * 512 + h * 128, 32, WSP(bf16, WS_MKP) + ((size_t)l * 512 + b * 256) * 512 + h * 128, WSP(bf16, WS_MVTP) + ((size_t)(l * 2 + b) * 4 + h) * 128 * 256, WSP(bf16, WS_MO) + row0 * 512 + h * 128, F.lane); }
          else { const int bh = it - 2048, b = bh >> 2, h = bh & 3; const size_t row0 = (size_t)MP + 16 * b;
              memattn_item(WSP(bf16, WS_MQ) + row0 * 512 + h * 128, 16, WSP(bf16, WS_MKS) + ((size_t)(l * 16 + b) * 256) * 512 + h * 128, WSP(bf16, WS_MVTS) + ((size_t)(l * 16 + b) * 4 + h) * 128 * 256, WSP(bf16, WS_MO) + row0 * 512 + h * 128, F.lane); }
      } }
#endif
#ifndef SKIP_POOL
    p_poolmix(F, l);
#endif
}

constexpr int PH_PER_LAYER = 9, N_PHASES = 2 + DEPTH * PH_PER_LAYER;
__global__ void __launch_bounds__(NWAVES * 64, 2) enc_fwd(Args args) {
    extern __shared__ __attribute__((aligned(16))) unsigned char lds[];
    Frame F;
    F.lds = (LAS unsigned char*)lds;
    F.tid = threadIdx.x; F.lane = F.tid & 63; F.wave = __builtin_amdgcn_readfirstlane(F.tid >> 6);
    F.G = gridDim.x; { const int bx = blockIdx.x; F.vcu = (F.G % 8 == 0) ? (bx % 8) * (F.G / 8) + bx / 8 : bx; }
    F.in = args.in; F.out = args.out; F.ws = args.ws;
    volatile LAS unsigned* MISC = (volatile LAS unsigned*)(F.lds + MISC_OFF);
    for (int u = F.tid; u < (LDS_BYTES - LDSCTL_OFF) / 4; u += NWAVES * 64) ((LAS unsigned*)(F.lds + LDSCTL_OFF))[u] = 0u;
    __syncthreads();
    unsigned* ctl = (unsigned*)(args.ws + WS_CTL);
    XcdBarrier bar; bar.bar = ctl + CW_BAR; bar.x = 0; bar.st = nullptr;
    if (args.use_bar) bar = xcd_barrier_post(ctl + CW_BAR, MISC + 8);
    const int lo = args.ph_lo, hi = args.ph_hi;
#define IN(k) (lo <= (k) && (k) < hi)
#define RELAUNDER() do { int t_ = threadIdx.x; asm volatile("" : "+v"(t_)); F.tid = t_; F.lane = t_ & 63; F.wave = __builtin_amdgcn_readfirstlane(t_ >> 6); } while (0)
#define SEAM(k) do { if (IN(k) && IN((k) + 1)) xcd_barrier(bar); } while (0)

#ifndef SKIP_PRO
    if (IN(0)) { p_prologue0(F); } SEAM(0);
#endif
    if (IN(1)) {
        pg8::Gemm g{WSP(pg8::bf16_t, WS_MEMA), WSP(pg8::bf16_t, WS_WMEM), 512, 4096, 1024}; pg8::StaticOrder S; S.init(512, 4096, F.G, (int)blockIdx.x);
        EpiMemKV E{F.ws, F.out};
        pg8::gemm_phase<EpiMemKV, pg8::StaticOrder, true, true>(F.lds + RING_OFF, g, S, E);
    } SEAM(1);
    for (int l = 0; l < DEPTH; ++l) {
        const int pb = 2 + l * PH_PER_LAYER;
        int Gl = F.G, bxl = (int)blockIdx.x; asm volatile("" : "+s"(Gl), "+s"(bxl));
        const pg8::bf16_t* WL = WSP(pg8::bf16_t, WS_W) + (size_t)l * WE_LAYER;
        if (IN(pb + 0)) {
            pg8::Gemm g{WSP(pg8::bf16_t, WS_H), WL + WE_IN, MT, NIN, 1024}; pg8::StaticOrder S; S.init(MT, NIN, Gl, bxl);
            EpiIn E{F.ws, F.out, F.in[12] + (size_t)l * 3072, F.in[11] + l * 8, l};
            pg8::gemm_phase<EpiIn, pg8::StaticOrder, true, true>(F.lds + RING_OFF, g, S, E);
        } SEAM(pb + 0);
        if (IN(pb + 1)) { RELAUNDER(); p_attn(F, l, (char*)lds, Gl, bxl); } SEAM(pb + 1);
        if (IN(pb + 2)) {
            pg8::StaticOrder S; S.init(MT, 1024, Gl, bxl);
            { pg8::Gemm g{WSP(pg8::bf16_t, WS_AO), WL + WE_F, MT, 1024, 512}; EpiBranch<0> E{F.ws}; pg8::gemm_phase<EpiBranch<0>, pg8::StaticOrder, true, true>(F.lds + RING_OFF, g, S, E); }
            { pg8::Gemm g{WSP(pg8::bf16_t, WS_MIX), WL + WE_P, MT, 1024, 512}; EpiBranch<1> E{F.ws}; pg8::gemm_phase<EpiBranch<1>, pg8::StaticOrder, true, true>(F.lds + RING_OFF, g, S, E); }
            { pg8::Gemm g{WSP(pg8::bf16_t, WS_MO), WL + WE_M, MT, 1024, 512}; EpiBranch<2> E{F.ws}; pg8::gemm_phase<EpiBranch<2>, pg8::StaticOrder, true, true>(F.lds + RING_OFF, g, S, E); }
        } SEAM(pb + 2);
        if (IN(pb + 3)) {
            pg8::Gemm g{WSP(pg8::bf16_t, WS_MRG), WL + WE_O, MT, 1024, 1024}; pg8::StaticOrder S; S.init(MT, 1024, Gl, bxl);
            EpiF32 E{WSP(float, WS_OUTF)};
            pg8::gemm_phase<EpiF32, pg8::StaticOrder, true, true>(F.lds + RING_OFF, g, S, E);
        } SEAM(pb + 3);
        if (IN(pb + 4)) { RELAUNDER(); p_postnorm(F, l, F.in[22] + l * 1024, l == 0, true); } SEAM(pb + 4);
        if (IN(pb + 5)) {
            pg8::Gemm g{WSP(pg8::bf16_t, WS_H), WL + WE_UP, MT, NUP, 1024}; pg8::StaticOrder S; S.init(MT, NUP, Gl, bxl);
            EpiUp E{F.ws, F.out, l};
            pg8::gemm_phase<EpiUp, pg8::StaticOrder, true, true>(F.lds + RING_OFF, g, S, E);
        } SEAM(pb + 5);
#ifndef SKIP_CONV
        if (IN(pb + 6)) { RELAUNDER(); p_conv(F, l); } SEAM(pb + 6);
#endif
        if (IN(pb + 7)) {
            pg8::Gemm g{WSP(pg8::bf16_t, WS_HH), WL + WE_DN, MT, 1024, DFF}; pg8::StaticOrder S; S.init(MT, 1024, Gl, bxl);
            EpiF32 E{WSP(float, WS_OUTF)};
            pg8::gemm_phase<EpiF32, pg8::StaticOrder, true, true>(F.lds + RING_OFF, g, S, E);
        } SEAM(pb + 7);
        if (IN(pb + 8)) { RELAUNDER(); p_postnorm(F, l, F.in[24] + l * 1024, false, l + 1 < DEPTH); } SEAM(pb + 8);
    }
#undef IN
#undef SEAM
}

#ifndef N_LAUNCH_MODE
#define N_LAUNCH_MODE 0
#endif
extern "C" void kernel_launch(void* const* d_in, const int* in_sizes, int n_in, void* d_out, int out_size, void* d_ws, size_t ws_size, hipStream_t stream) {
    static int grid = 0;
    if (grid == 0) {
        if (n_in != 29 || (size_t)out_size != O_END || ws_size < WS_END) { fprintf(stderr, "kernel_launch: unexpected problem (n_in %d out %d ws %zu need %zu)\n", n_in, out_size, ws_size, (size_t)WS_END); grid = -1; return; }
        int dev = 0, cus = 0, per_cu = 0;
        if (hipGetDevice(&dev) != hipSuccess || hipDeviceGetAttribute(&cus, hipDeviceAttributeMultiprocessorCount, dev) != hipSuccess) { grid = -1; return; }
        if (hipFuncSetAttribute((const void*)enc_fwd, hipFuncAttributeMaxDynamicSharedMemorySize, LDS_BYTES) != hipSuccess) { fprintf(stderr, "kernel_launch: hipFuncSetAttribute failed\n"); grid = -1; return; }
        if (hipOccupancyMaxActiveBlocksPerMultiprocessor(&per_cu, (const void*)enc_fwd, NWAVES * 64, LDS_BYTES) != hipSuccess || per_cu < 1) fprintf(stderr, "kernel_launch: occupancy query says %d\n", per_cu);
        (void)hipGetLastError();
        grid = cus;
    }
    if (grid < 0) return;
    if (hipMemsetAsync((char*)d_ws + WS_CTL, 0, CTL_ZERO_BYTES, stream) != hipSuccess) return;
    Args a{};
    for (int i = 0; i < 29; ++i) a.in[i] = (const float*)d_in[i];
    a.out = (float*)d_out; a.ws = (unsigned char*)d_ws; a.pad = 0;
#if N_LAUNCH_MODE == 1
    a.ph_lo = 0; a.ph_hi = N_PHASES; a.use_bar = 1;
    hipLaunchKernelGGL(enc_fwd, dim3(grid), dim3(NWAVES * 64), LDS_BYTES, stream, a);
#else
    for (int p = 0; p < N_PHASES; ++p) { a.ph_lo = p; a.ph_hi = p + 1; a.use_bar = 0;
        hipLaunchKernelGGL(enc_fwd, dim3(grid), dim3(NWAVES * 64), LDS_BYTES, stream, a); }
#endif
}
```
